# Optimizing an MI355X kernel written in HIP

```python
import math
import jax, jax.numpy as jnp
from jax import lax
import numpy as np

D_MODEL = 1024
BATCH = 16
SEQ = 2048
DEPTH = 1

N_FOX_HEADS = 8
FOX_HEAD_DIM = 64
FOX_WIDTH = N_FOX_HEADS * FOX_HEAD_DIM
N_DIFF_HEADS = 4
DIFF_QK_DIM = 64
DIFF_V_DIM = 2 * DIFF_QK_DIM
DIFF_QK_WIDTH = N_DIFF_HEADS * 2 * DIFF_QK_DIM
DIFF_WIDTH = N_DIFF_HEADS * DIFF_V_DIM
MIX_WIDTH = FOX_WIDTH + DIFF_WIDTH
IN_SIZES = (FOX_WIDTH, FOX_WIDTH, FOX_WIDTH, N_FOX_HEADS,
            DIFF_QK_WIDTH, DIFF_QK_WIDTH, DIFF_WIDTH)
IN_WIDTH = sum(IN_SIZES)
IN_SPLITS = tuple(int(v) for v in np.cumsum(IN_SIZES)[:-1])
ROPE_THETA = 500000.0
ROPE_DIM = DIFF_QK_DIM // 4
D_FF = 2816
FFN_RESIDUAL_WEIGHT = 0.5
Q_BLOCK = 128
RMS_EPS = 1e-6

kernel_name = "hybrid_fox_diffattn_macaron_layer"


def rms_norm(x, g):
    xf = x.astype(jnp.float32)
    y = xf * lax.rsqrt(jnp.mean(xf * xf, axis=-1, keepdims=True) + RMS_EPS)
    return (y * g.astype(jnp.float32)).astype(x.dtype)


def swiglu(x, w_gate, w_up, w_down):
    return (jax.nn.silu(x @ w_gate) * (x @ w_up)) @ w_down


def to_heads(t, n_heads):
    b, s, _ = t.shape
    return t.reshape(b, s, n_heads, -1).transpose(0, 2, 1, 3)


def from_heads(t):
    b, h, s, d = t.shape
    return t.transpose(0, 2, 1, 3).reshape(b, s, h * d)


def partial_rope(t, pos):
    half = ROPE_DIM // 2
    inv_freq = ROPE_THETA ** (-jnp.arange(0, ROPE_DIM, 2, dtype=jnp.float32) / ROPE_DIM)
    ang = pos.astype(jnp.float32)[:, None] * inv_freq[None, :]
    cos, sin = jnp.cos(ang), jnp.sin(ang)
    tf = t.astype(jnp.float32)
    x1, x2, rest = tf[..., :half], tf[..., half:ROPE_DIM], tf[..., ROPE_DIM:]
    out = jnp.concatenate([x1 * cos - x2 * sin, x2 * cos + x1 * sin, rest], axis=-1)
    return out.astype(t.dtype)


def causal_block_attention(q, k, v, log_decay_cum=None):
    seq = q.shape[2]
    scale = q.shape[-1] ** -0.5
    outs = []
    for i in range(seq // Q_BLOCK):
        q0, q1 = i * Q_BLOCK, (i + 1) * Q_BLOCK
        s = jnp.einsum('bhqd,bhkd->bhqk', q[:, :, q0:q1], k[:, :, :q1]).astype(jnp.float32) * scale
        if log_decay_cum is not None:
            s = s + log_decay_cum[:, :, q0:q1, None] - log_decay_cum[:, :, None, :q1]
        mask = jnp.arange(q1)[None, :] <= jnp.arange(q0, q1)[:, None]
        s = jnp.where(mask, s, jnp.finfo(jnp.float32).min)
        p = jax.nn.softmax(s, axis=-1).astype(v.dtype)
        outs.append(jnp.einsum('bhqk,bhkd->bhqd', p, v[:, :, :q1]))
    return jnp.concatenate(outs, axis=2)


def token_mixer(h, w_in, fox_forget_b, lam_q1, lam_k1, lam_q2, lam_k2, subln_g, w_out, layer):
    b, s, _ = h.shape
    pos = jnp.arange(s)
    proj = h @ w_in
    fq, fk, fv, fgate, dq, dk, dv = jnp.split(proj, IN_SPLITS, axis=-1)

    log_f = jax.nn.log_sigmoid(fgate.astype(jnp.float32) + fox_forget_b.astype(jnp.float32))
    c = jnp.cumsum(log_f, axis=1).transpose(0, 2, 1)
    fox_o = causal_block_attention(to_heads(fq, N_FOX_HEADS), to_heads(fk, N_FOX_HEADS),
                                   to_heads(fv, N_FOX_HEADS), c)
    fox_o = from_heads(fox_o)

    dq = dq.reshape(b, s, N_DIFF_HEADS, 2, DIFF_QK_DIM)
    dk = dk.reshape(b, s, N_DIFF_HEADS, 2, DIFF_QK_DIM)
    hd = lambda t: partial_rope(t.transpose(0, 2, 1, 3), pos)
    q1, q2 = hd(dq[..., 0, :]), hd(dq[..., 1, :])
    k1, k2 = hd(dk[..., 0, :]), hd(dk[..., 1, :])
    v = to_heads(dv, N_DIFF_HEADS)
    lam_init = 0.8 - 0.6 * math.exp(-0.3 * layer)
    lam = (jnp.exp(jnp.sum(lam_q1.astype(jnp.float32) * lam_k1.astype(jnp.float32)))
           - jnp.exp(jnp.sum(lam_q2.astype(jnp.float32) * lam_k2.astype(jnp.float32)))
           + lam_init)
    a1 = causal_block_attention(q1, k1, v)
    a2 = causal_block_attention(q2, k2, v)
    diff_o = a1 - lam.astype(a1.dtype) * a2
    diff_o = rms_norm(diff_o, subln_g) * (1.0 - lam_init)
    diff_o = from_heads(diff_o)

    return jnp.concatenate([fox_o, diff_o], axis=-1) @ w_out


def setup_inputs(seed: int = 0) -> dict:
    key = jax.random.key(seed)
    ks = jax.random.split(key, 24)
    L = DEPTH
    nrm = lambda k, shape, scale: jax.random.normal(k, shape, jnp.float32) * scale
    gain = lambda k, n: 1.0 + 0.02 * jax.random.normal(k, (L, n), jnp.float32)
    return {
        "x": jax.random.normal(ks[0], (BATCH, SEQ, D_MODEL), jnp.float32),
        "ffn1_pre_g": gain(ks[1], D_MODEL),
        "ffn1_post_g": gain(ks[2], D_MODEL),
        "ffn1_w_gate": nrm(ks[3], (L, D_MODEL, D_FF), D_MODEL ** -0.5),
        "ffn1_w_up": nrm(ks[4], (L, D_MODEL, D_FF), D_MODEL ** -0.5),
        "ffn1_w_down": nrm(ks[5], (L, D_FF, D_MODEL), D_FF ** -0.5),
        "mix_pre_g": gain(ks[6], D_MODEL),
        "mix_post_g": gain(ks[7], D_MODEL),
        "w_in": nrm(ks[8], (L, D_MODEL, IN_WIDTH), D_MODEL ** -0.5),
        "fox_forget_b": nrm(ks[9], (L, N_FOX_HEADS), 0.02),
        "diff_lambda_q1": nrm(ks[10], (L, DIFF_QK_DIM), 0.1),
        "diff_lambda_k1": nrm(ks[11], (L, DIFF_QK_DIM), 0.1),
        "diff_lambda_q2": nrm(ks[12], (L, DIFF_QK_DIM), 0.1),
        "diff_lambda_k2": nrm(ks[13], (L, DIFF_QK_DIM), 0.1),
        "diff_subln_g": gain(ks[14], DIFF_V_DIM),
        "w_out": nrm(ks[15], (L, MIX_WIDTH, D_MODEL), MIX_WIDTH ** -0.5),
        "ffn2_pre_g": gain(ks[16], D_MODEL),
        "ffn2_post_g": gain(ks[17], D_MODEL),
        "ffn2_w_gate": nrm(ks[18], (L, D_MODEL, D_FF), D_MODEL ** -0.5),
        "ffn2_w_up": nrm(ks[19], (L, D_MODEL, D_FF), D_MODEL ** -0.5),
        "ffn2_w_down": nrm(ks[20], (L, D_FF, D_MODEL), D_FF ** -0.5),
    }


def reference(x, ffn1_pre_g, ffn1_post_g, ffn1_w_gate, ffn1_w_up, ffn1_w_down,
              mix_pre_g, mix_post_g, w_in, fox_forget_b,
              diff_lambda_q1, diff_lambda_k1, diff_lambda_q2, diff_lambda_k2, diff_subln_g,
              w_out, ffn2_pre_g, ffn2_post_g, ffn2_w_gate, ffn2_w_up, ffn2_w_down):
    for l in range(DEPTH):
        f1 = swiglu(rms_norm(x, ffn1_pre_g[l]), ffn1_w_gate[l], ffn1_w_up[l], ffn1_w_down[l])
        x = x + FFN_RESIDUAL_WEIGHT * rms_norm(f1, ffn1_post_g[l])
        m = token_mixer(rms_norm(x, mix_pre_g[l]), w_in[l], fox_forget_b[l],
                        diff_lambda_q1[l], diff_lambda_k1[l], diff_lambda_q2[l], diff_lambda_k2[l],
                        diff_subln_g[l], w_out[l], l)
        x = x + rms_norm(m, mix_post_g[l])
        f2 = swiglu(rms_norm(x, ffn2_pre_g[l]), ffn2_w_gate[l], ffn2_w_up[l], ffn2_w_down[l])
        x = x + FFN_RESIDUAL_WEIGHT * rms_norm(f2, ffn2_post_g[l])
    return x
```

```cpp
#include <hip/hip_runtime.h>
#include <cstdio>
#include <cstdint>
__device__ __forceinline__ int lane_id() { int l; asm volatile("v_mbcnt_lo_u32_b32 %0, -1, 0\n\tv_mbcnt_hi_u32_b32 %0, -1, %0" : "=v"(l)); return l; }
__device__ __forceinline__ float shfl_xor_l(float x, int mask, int lane) { return __builtin_bit_cast(float, __builtin_amdgcn_ds_bpermute((lane ^ mask) << 2, __builtin_bit_cast(int, x))); }
__device__ __forceinline__ float xsum16(float v) { const auto r = __builtin_amdgcn_permlane16_swap(__float_as_uint(v), __float_as_uint(v), false, false); return __uint_as_float(r[0]) + __uint_as_float(r[1]); }
__device__ __forceinline__ float rowsum16(float v) {
    v += __builtin_bit_cast(float, __builtin_amdgcn_update_dpp(0, __builtin_bit_cast(int, v), 0xB1, 0xF, 0xF, true));
    v += __builtin_bit_cast(float, __builtin_amdgcn_update_dpp(0, __builtin_bit_cast(int, v), 0x4E, 0xF, 0xF, true));
    v += __builtin_bit_cast(float, __builtin_amdgcn_update_dpp(0, __builtin_bit_cast(int, v), 0x124, 0xF, 0xF, true));
    v += __builtin_bit_cast(float, __builtin_amdgcn_update_dpp(0, __builtin_bit_cast(int, v), 0x128, 0xF, 0xF, true));
    return v; }
__device__ __forceinline__ float rowmax16(float v) {
    v = __builtin_fmaxf(v, __builtin_bit_cast(float, __builtin_amdgcn_update_dpp(0, __builtin_bit_cast(int, v), 0xB1, 0xF, 0xF, true)));
    v = __builtin_fmaxf(v, __builtin_bit_cast(float, __builtin_amdgcn_update_dpp(0, __builtin_bit_cast(int, v), 0x4E, 0xF, 0xF, true)));
    v = __builtin_fmaxf(v, __builtin_bit_cast(float, __builtin_amdgcn_update_dpp(0, __builtin_bit_cast(int, v), 0x124, 0xF, 0xF, true)));
    v = __builtin_fmaxf(v, __builtin_bit_cast(float, __builtin_amdgcn_update_dpp(0, __builtin_bit_cast(int, v), 0x128, 0xF, 0xF, true)));
    return v; }
__device__ __forceinline__ float xsum32(float v) { const auto r = __builtin_amdgcn_permlane32_swap(__float_as_uint(v), __float_as_uint(v), false, false); return __uint_as_float(r[0]) + __uint_as_float(r[1]); }
__device__ __forceinline__ float shfl_idx_l(float x, int src) { return __builtin_bit_cast(float, __builtin_amdgcn_ds_bpermute(src << 2, __builtin_bit_cast(int, x))); }
__device__ __forceinline__ int opaque_s(int v) { asm volatile("" : "+s"(v)); return v; }
namespace pg8 {
#define PG8_LAS __attribute__((address_space(3)))
typedef unsigned short bf16_t;
typedef short bf16x8 __attribute__((ext_vector_type(8)));
typedef float f32x4 __attribute__((ext_vector_type(4)));
typedef unsigned u32x4 __attribute__((ext_vector_type(4)));
constexpr int BM = 256, BK = 64, HALF = 128, HTB = HALF * BK * 2  , STAGE_BYTES = 8 * HTB, NXCD = 8;
#ifndef PG8_WGM
#define PG8_WGM 8
#endif
constexpr int WGM = PG8_WGM;

__host__ __device__ __forceinline__ int lds_byte(int r, int c) { const int st = (r >> 4) * 2 + (c >> 5), rr = r & 15, cc = c & 31, ob = rr * 64 + cc * 2; return st * 1024 + (ob ^ (((ob >> 9) & 1) << 5)); }
__host__ __device__ __forceinline__ void stage_rc(int b, int& R, int& C) { const int st = b / 1024, sb = b % 1024, swz = sb ^ (((sb >> 9) & 1) << 5); R = (st >> 1) * 16 + swz / 64; C = (st & 1) * 32 + (swz % 64) / 2; }
__host__ __device__ __forceinline__ int perm32(int rho) { const int n = rho >> 4, i = rho & 15; return 8 * (i >> 2) + 4 * n + (i & 3); }

struct Unit { int pm, pn; };
struct Gemm { const bf16_t* A; const bf16_t* Bt; int M, N, K; int apad = 0; };

struct StaticOrder {
    int nM, nN, nwg, G, c, wgm, rev;
    __host__ __device__ void init(int M, int N, int G_, int c_, int wgm_ = WGM, int rev_ = 0) { nM = M / BM; nN = N / BM; nwg = nM * nN; G = G_; c = c_; wgm = wgm_; rev = rev_; }
    __host__ __device__ bool next(int i, Unit& u) const {
        const long L = (long)i * G + c; if (L >= nwg) return false;
        int wgid = (int)L; { const int q = nwg / NXCD, r = nwg % NXCD, xcd = wgid % NXCD, off = wgid / NXCD; wgid = (xcd < r ? xcd * (q + 1) : r * (q + 1) + (xcd - r) * q) + off; }
        const int nig = wgm * nN, gid = wgid / nig, fm = gid * wgm, gsz = (nM - fm) < wgm ? (nM - fm) : wgm;
        u.pm = (fm + ((wgid % nig) % gsz)) ^ rev; u.pn = (wgid % nig) / gsz; return true;
    }
    __device__ __forceinline__ void a_ready(const Unit&) const {}
    __device__ __forceinline__ void done(const Unit&) const {}
};


__device__ __forceinline__ unsigned cvt_pk_bf16(float lo, float hi) { unsigned r; asm volatile("v_cvt_pk_bf16_f32 %0, %1, %2" : "=v"(r) : "v"(lo), "v"(hi)); return r; }
typedef float f32x2 __attribute__((ext_vector_type(2)));
__device__ __forceinline__ f32x2 swiglu_pk(f32x2 g, f32x2 u) {
    f32x2 e; e.x = __builtin_amdgcn_exp2f(g.x); e.y = __builtin_amdgcn_exp2f(g.y);
    const f32x2 d = e + 1.0f; f32x2 r; r.x = __builtin_amdgcn_rcpf(d.x); r.y = __builtin_amdgcn_rcpf(d.y);
    return (g * u) * r;
}

struct EpiSwiglu {
    static constexpr bool PERM = true, AFTER_DRAIN = false, INLOOP_LDS = false;
    bf16_t* O; int ldc; int opad;
    __device__ __forceinline__ void operator()(const f32x4 (&acc)[2][2][4][2], const Unit& u, int wr, int wc, int fr, int fq) const {
        const int row0 = u.pm * BM + wr * 64 + fr; const int col0 = u.pn * HALF + wc * 32 + 8 * fq;
        bf16_t* Oc = O + (size_t)(u.pm >> 4) * (size_t)opad;
#pragma unroll
        for (int ai = 0; ai < 2; ++ai)
#pragma unroll
            for (int m = 0; m < 4; ++m) { bf16_t* rowp = Oc + (size_t)(row0 + ai * HALF + m * 16) * ldc + col0;
                const f32x4 g0 = acc[ai][0][m][0], g1 = acc[ai][0][m][1], u0 = acc[ai][1][m][0], u1 = acc[ai][1][m][1];
                const f32x2 a = swiglu_pk((f32x2){g0[0], g0[1]}, (f32x2){u0[0], u0[1]}), b = swiglu_pk((f32x2){g0[2], g0[3]}, (f32x2){u0[2], u0[3]});
                const f32x2 c = swiglu_pk((f32x2){g1[0], g1[1]}, (f32x2){u1[0], u1[1]}), d = swiglu_pk((f32x2){g1[2], g1[3]}, (f32x2){u1[2], u1[3]});
                u32x4 w; w.x = cvt_pk_bf16(a.x, a.y); w.y = cvt_pk_bf16(b.x, b.y); w.z = cvt_pk_bf16(c.x, c.y); w.w = cvt_pk_bf16(d.x, d.y);
                *(u32x4*)rowp = w; }
    }
};

struct EpiQKV {
    static constexpr bool PERM = true, AFTER_DRAIN = false, INLOOP_LDS = false;
    bf16_t* O; int ldc; const float* rope; float c2; int seq_mask; unsigned* stat;
    __device__ __forceinline__ void operator()(const f32x4 (&acc)[2][2][4][2], const Unit& u, int wr, int wc, int fr, int fq) const {
        const int row0 = u.pm * BM + wr * 64 + fr; const int region = u.pn >> 1;
        const float sc = (region == 0 || region == 3) ? c2 : 1.f;
        const bool roper = (region == 3 || region == 4) && ((wc & 1) == 0) && (fq < 2);
        const int col0 = u.pn * BM + wc * 32 + 8 * fq;
        if (region <= 1) {
            const int lane = fq * 16 + fr;
#pragma unroll
            for (int bj = 0; bj < 2; ++bj) { float mx = 0.f;
#pragma unroll
                for (int ai = 0; ai < 2; ++ai)
#pragma unroll
                    for (int m = 0; m < 4; ++m) { const f32x4 a = acc[ai][bj][m][0] * sc, b = acc[ai][bj][m][1] * sc;
                        float s = ((a[0] * a[0] + a[1] * a[1]) + (a[2] * a[2] + a[3] * a[3])) + ((b[0] * b[0] + b[1] * b[1]) + (b[2] * b[2] + b[3] * b[3]));
                        s = xsum32(xsum16(s)); mx = __builtin_fmaxf(mx, s); }
                mx = rowmax16(mx);
                if (lane == 0) __hip_atomic_fetch_max(stat + (((u.pm >> 3) * 8 + (u.pn & 1) * 4 + bj * 2 + (wc >> 1)) * 2 + region), __float_as_uint(mx), __ATOMIC_RELAXED, __HIP_MEMORY_SCOPE_AGENT); }
        }
        if (region == 3 || region == 4) {
            f32x4 csv[2][4], snv[2][4];
#pragma unroll
            for (int ai = 0; ai < 2; ++ai)
#pragma unroll
                for (int m = 0; m < 4; ++m) { const int row = row0 + ai * HALF + m * 16; const float* rp = rope + (size_t)(row & seq_mask) * 16 + 4 * (fq & 1); csv[ai][m] = *(const f32x4*)rp; snv[ai][m] = *(const f32x4*)(rp + 8); }
#pragma unroll
            for (int ai = 0; ai < 2; ++ai)
#pragma unroll
                for (int m = 0; m < 4; ++m) { const int row = row0 + ai * HALF + m * 16; bf16_t* rowp = O + (size_t)row * ldc + col0;
                    const f32x4 cs = roper ? csv[ai][m] : (f32x4){1.f, 1.f, 1.f, 1.f}, sn = roper ? snv[ai][m] : (f32x4){0.f, 0.f, 0.f, 0.f};
#pragma unroll
                    for (int bj = 0; bj < 2; ++bj) { const f32x4 x0 = acc[ai][bj][m][0], x1 = acc[ai][bj][m][1];
                        const f32x4 v0 = (x0 * cs - x1 * sn) * sc, v1 = (x1 * cs + x0 * sn) * sc;
                        u32x4 w; w.x = cvt_pk_bf16(v0[0], v0[1]); w.y = cvt_pk_bf16(v0[2], v0[3]); w.z = cvt_pk_bf16(v1[0], v1[1]); w.w = cvt_pk_bf16(v1[2], v1[3]);
                        *(u32x4*)(rowp + bj * HALF) = w; } }
        } else {
#pragma unroll
        for (int ai = 0; ai < 2; ++ai)
#pragma unroll
            for (int m = 0; m < 4; ++m) { const int row = row0 + ai * HALF + m * 16; bf16_t* rowp = O + (size_t)row * ldc + col0;
#pragma unroll
                for (int bj = 0; bj < 2; ++bj) { const f32x4 v0 = acc[ai][bj][m][0] * sc, v1 = acc[ai][bj][m][1] * sc;
                    u32x4 w; w.x = cvt_pk_bf16(v0[0], v0[1]); w.y = cvt_pk_bf16(v0[2], v0[3]); w.z = cvt_pk_bf16(v1[0], v1[1]); w.w = cvt_pk_bf16(v1[2], v1[3]);
                    *(u32x4*)(rowp + bj * HALF) = w; } }
        }
    }
};

#define PG8_GAS __attribute__((address_space(1)))
__device__ __forceinline__ f32x4 bf16x4_to_f32(unsigned lo, unsigned hi) { return (f32x4){__uint_as_float(lo << 16), __uint_as_float(lo & 0xffff0000u), __uint_as_float(hi << 16), __uint_as_float(hi & 0xffff0000u)}; }
__device__ __forceinline__ float dot4(f32x4 a, f32x4 b) { return (a[0] * b[0] + a[1] * b[1]) + (a[2] * b[2] + a[3] * b[3]); }
template <bool FINAL, int W2  > struct EpiFused {
    static constexpr bool PERM = true, AFTER_DRAIN = false, INLOOP_LDS = true;
    static constexpr float w = 0.5f * W2, eps = 1e-6f;
    const bf16_t* xin; const float* rms_in; bf16_t* xn; float* rms_out; float* out; const float* g; int ldc;
    unsigned long long* xbuf;
    unsigned* cnt;
    unsigned* tmo; unsigned code; unsigned poison;
#ifndef EPI_POLL_SLEEP
#define EPI_POLL_SLEEP 4
#endif
    static constexpr unsigned long long SENT = ~0ull;
    static constexpr int LDS_S = 16384, LDS_FLAG = LDS_S + 4096, LDS_G = LDS_FLAG + 64, LDS_END = LDS_G + 4096;
    __device__ __forceinline__ void fill_gains(PG8_LAS unsigned char* lds, int tid) const {
        for (int i = tid; i < 1024; i += 512) ((PG8_LAS float*)(lds + LDS_G))[i] = g[i] * w;
    }
    __device__ __forceinline__ void fused(f32x4 (&acc)[2][2][4][2], const Unit& u, int, int, int, int, PG8_LAS unsigned char* lds, int wid_in, int) const {
        const int wid = opaque_s(wid_in), lane = lane_id(), wr = wid >> 2, wc = wid & 3, fr = lane & 15, fq = lane >> 4;
        PG8_LAS f32x4* P = (PG8_LAS f32x4*)lds;
        PG8_LAS f32x4* S = (PG8_LAS f32x4*)(lds + LDS_S);
        PG8_LAS unsigned* flag = (PG8_LAS unsigned*)(lds + LDS_FLAG);
        const PG8_LAS f32x4* G4 = (const PG8_LAS f32x4*)(lds + LDS_G);
        const int col0 = u.pn * BM + wc * 32 + 8 * fq;
        const PG8_GAS unsigned char* xin_g = (const PG8_GAS unsigned char*)xin; const PG8_GAS float* rms_g = (const PG8_GAS float*)rms_in;
        const int row = wid * 32 + (lane & 31);
        u32x4 bsr[2][4][2];
#define EPIF_LOAD_RES() do { _Pragma("unroll") for (int ai = 0; ai < 2; ++ai) _Pragma("unroll") for (int m = 0; m < 4; ++m) { const int r = ai * HALF + wr * 64 + m * 16 + fr; const unsigned off = (unsigned)((u.pm * BM + r) * ldc + col0) * 2u; \
            _Pragma("unroll") for (int bj = 0; bj < 2; ++bj) bsr[ai][m][bj] = *(const PG8_GAS u32x4*)(xin_g + off + (bj * HALF) * 2); } } while (0)
        if (!FINAL) EPIF_LOAD_RES();
        {
        int gidx = col0 >> 2;
#pragma unroll
        for (int ai = 0; ai < 2; ++ai) {
#pragma unroll
            for (int m = 0; m < 4; ++m) { float sff = 0.f, saa = 0.f, sxx = 0.f, sax = 0.f;
                if (!FINAL) asm volatile("" : "+v"(gidx));
#pragma unroll
                for (int bj = 0; bj < 2; ++bj)
#pragma unroll
                    for (int n = 0; n < 2; ++n) { const f32x4 f = acc[ai][bj][m][n]; sff += dot4(f, f);
                        if (!FINAL) { const f32x4 a = f * G4[gidx + 32 * bj + n]; acc[ai][bj][m][n] = a; const f32x4 xb = (n == 0 ? bf16x4_to_f32(bsr[ai][m][bj].x, bsr[ai][m][bj].y) : bf16x4_to_f32(bsr[ai][m][bj].z, bsr[ai][m][bj].w)); saa += dot4(a, a); sxx += dot4(xb, xb); sax += dot4(a, xb); } }
                sff = xsum32(xsum16(sff));
                if (!FINAL) { saa = xsum32(xsum16(saa)); sxx = xsum32(xsum16(sxx)); sax = xsum32(xsum16(sax)); }
                if (fq == 0) P[(ai * HALF + wr * 64 + m * 16 + fr) * 4 + wc] = (f32x4){sff, saa, sxx, sax};
            }
        }
        }
        const float rinr = *(const PG8_GAS float*)((const PG8_GAS unsigned char*)rms_g + (unsigned)(u.pm * BM + row) * 4u);
        asm volatile("s_waitcnt lgkmcnt(0)" ::: "memory"); __builtin_amdgcn_s_barrier(); asm volatile("" ::: "memory");
        unsigned long long* const slot0 = xbuf + (size_t)u.pm * (8 * BM) + row;
        if (lane < 32) {
            f32x4 t = (P[row * 4 + 0] + P[row * 4 + 1]) + (P[row * 4 + 2] + P[row * 4 + 3]);
            t[2] *= rinr * rinr; t[3] *= rinr;
            unsigned long long w0 = ((unsigned long long)__float_as_uint(t[1]) << 32) | __float_as_uint(t[0]), w1 = ((unsigned long long)__float_as_uint(t[3]) << 32) | __float_as_uint(t[2]);
            if (w0 == SENT) w0 = 0x7fc000007fc00000ull; if (w1 == SENT) w1 = 0x7fc000007fc00000ull;
            __hip_atomic_store(slot0 + (2 * u.pn) * BM, w0, __ATOMIC_RELAXED, __HIP_MEMORY_SCOPE_AGENT);
            __hip_atomic_store(slot0 + (2 * u.pn + 1) * BM, w1, __ATOMIC_RELAXED, __HIP_MEMORY_SCOPE_AGENT);
        }
        if (FINAL) EPIF_LOAD_RES();
#undef EPIF_LOAD_RES
        {
            bool dead = false; unsigned spins = 0u;
            unsigned long long wv[8];
#pragma unroll
            for (int t = 0; t < 8; ++t) wv[t] = 0ull;
            for (;;) {
                bool ok = true;
                if (lane < 32) {
#pragma unroll
                    for (int t = 0; t < 8; ++t) wv[t] = __hip_atomic_load(slot0 + t * BM, __ATOMIC_RELAXED, __HIP_MEMORY_SCOPE_AGENT);
#pragma unroll
                    for (int t = 0; t < 8; ++t) ok = ok && (wv[t] != SENT);
                }
                if (__builtin_amdgcn_ballot_w64(!ok) == 0ull) break;
                if (++spins > 65536u) {
                    if (lane == 0) { unsigned expect = 0u; __hip_atomic_compare_exchange_strong(tmo + 1, &expect, code | (unsigned)(u.pm & 0xff), __ATOMIC_RELAXED, __ATOMIC_RELAXED, __HIP_MEMORY_SCOPE_AGENT);
                                     __hip_atomic_store(tmo, 1u, __ATOMIC_RELAXED, __HIP_MEMORY_SCOPE_AGENT); }
                    dead = true; break; }
                __builtin_amdgcn_s_sleep(EPI_POLL_SLEEP);
            }
            if (dead && lane == 0) flag[0] = 1u;
            if (lane < 32) { float sff = 0.f, saa = 0.f, sbb = 0.f, sab = 0.f;
#pragma unroll
                for (int t = 0; t < 4; ++t) { const unsigned long long w0 = wv[2 * t], w1 = wv[2 * t + 1];
                    sff += __uint_as_float((unsigned)w0); saa += __uint_as_float((unsigned)(w0 >> 32)); sbb += __uint_as_float((unsigned)w1); sab += __uint_as_float((unsigned)(w1 >> 32)); }
                const float r1 = 1.0f / sqrtf(sff * (1.0f / 1024.0f) + eps);
                const float sx = sbb + 2.0f * r1 * sab + (r1 * r1) * saa;
                const float r2 = 1.0f / sqrtf(__builtin_fmaxf(sx, 0.f) * (1.0f / 1024.0f) + eps);
                S[row] = FINAL ? (f32x4){rinr, r1, 0.f, 0.f} : (f32x4){rinr * r2, r1 * r2, 1.0f / r2, 0.f};
            }
        }
        asm volatile("s_waitcnt lgkmcnt(0)" ::: "memory"); __builtin_amdgcn_s_barrier(); asm volatile("" ::: "memory");
        const bool bad = (flag[0] != 0u) || (poison != 0u);
#pragma unroll
        for (int ai = 0; ai < 2; ++ai)
#pragma unroll
            for (int m = 0; m < 4; ++m)
#pragma unroll
                for (int bj = 0; bj < 2; ++bj) asm volatile("" : "+v"(bsr[ai][m][bj]));
        const float qnan = __builtin_nanf("");
        { const int lane2 = lane_id(); const int fr2 = lane2 & 15, fq2 = lane2 >> 4; const int col2 = u.pn * BM + wc * 32 + 8 * fq2;
        const bool rms_writer = (u.pn == 0 && wc == 0 && fq2 == 0);
        int gidx2 = col2 >> 2;
#pragma unroll
        for (int ai = 0; ai < 2; ++ai) {
#pragma unroll
            for (int m = 0; m < 4; ++m) { const int r = ai * HALF + wr * 64 + m * 16 + fr2; const f32x4 cs = S[r];
                if (FINAL) asm volatile("" : "+v"(gidx2)); const unsigned off = (unsigned)((u.pm * BM + r) * ldc + col2);
                if (!FINAL && rms_writer) *(PG8_GAS float*)((PG8_GAS unsigned char*)rms_out + (unsigned)(u.pm * BM + r) * 4u) = cs.z;
#pragma unroll
                for (int bj = 0; bj < 2; ++bj) { u32x4 wv = (u32x4){0u, 0u, 0u, 0u};
#pragma unroll
                    for (int n = 0; n < 2; ++n) { const f32x4 xb = (n == 0 ? bf16x4_to_f32(bsr[ai][m][bj].x, bsr[ai][m][bj].y) : bf16x4_to_f32(bsr[ai][m][bj].z, bsr[ai][m][bj].w)); f32x4 o = xb * cs.x + (FINAL ? acc[ai][bj][m][n] * G4[gidx2 + 32 * bj + n] : acc[ai][bj][m][n]) * cs.y;
                        if (FINAL) { if (bad) o = (f32x4){qnan, qnan, qnan, qnan}; *(PG8_GAS f32x4*)((PG8_GAS unsigned char*)out + (off + bj * HALF + n * 4) * 4u) = o; }
                        else { const unsigned c0 = cvt_pk_bf16(o[0], o[1]), c1 = cvt_pk_bf16(o[2], o[3]); if (n == 0) { wv.x = c0; wv.y = c1; } else { wv.z = c0; wv.w = c1; } } }
                    if (!FINAL) { if (bad) wv = (u32x4){0x7fc07fc0u, 0x7fc07fc0u, 0x7fc07fc0u, 0x7fc07fc0u}; *(PG8_GAS u32x4*)((PG8_GAS unsigned char*)xn + (off + bj * HALF) * 2u) = wv; } }
            }
        }
        }
    }
};

template <class Epi, class Sched, bool ALIGN_EPI = false, bool SP2 = false>
__device__ __forceinline__ void gemm_phase(PG8_LAS unsigned char* lds, const Gemm g, const Sched& S, const Epi& E, const int wave_id  , PG8_LAS unsigned char* epi_lds = nullptr  ) {
    const int lane = lane_id(), wid = opaque_s(wave_id), tid = wid * 64 + lane,
              wr = wid >> 2, wc = wid & 3, fr = lane & 15, fq = lane >> 4;
    const int K = g.K, nt = K / BK;
    unsigned voffA[2], voffB[2];
#pragma unroll
    for (int i = 0; i < 2; ++i) { int R, C; stage_rc(tid * 16 + i * 8192, R, C); const int Rb = Epi::PERM ? ((R & ~31) + perm32(R & 31)) : R;
        voffA[i] = (unsigned)(R * K + C) * 2u; voffB[i] = (unsigned)(Rb * K + C) * 2u; }
    const size_t kstep = (size_t)(BK * 2);
    const size_t hstep = (size_t)HALF * K * 2;
    const size_t tstep = 2 * hstep;
    const unsigned ldsw = (unsigned)wid * 1024u;
    const int aoff = lds_byte(wr * 64 + fr, fq * 8), boff = lds_byte(wc * 32 + fr, fq * 8);
#define PG8_SA(b, h) (((b) * 2 + (h)) * HTB)
#define PG8_SB(b, h) ((4 + (b) * 2 + (h)) * HTB)
#define PG8_STAGE(bufoff, gbase, voff) do { _Pragma("unroll") for (int _i = 0; _i < 2; ++_i) { unsigned _v = (voff)[_i]; if (PG8_OPQ && Epi::INLOOP_LDS) asm volatile("" : "+v"(_v));   \
        __builtin_amdgcn_global_load_lds((const PG8_GAS unsigned*)((const PG8_GAS char*)(gbase) + _v), (PG8_LAS unsigned*)(lds + (bufoff) + ldsw + _i * 8192), 16, 0, PG8_DMA_AUX); } } while (0)
#define PG8_LDA(dst, b, h) do { _Pragma("unroll") for (int m = 0; m < 4; ++m) _Pragma("unroll") for (int k = 0; k < 2; ++k) dst[m][k] = *(const PG8_LAS bf16x8*)(lds + PG8_SA(b, h) + aoff + m * 2048 + k * 1024); } while (0)
#define PG8_LDB(dst, b, h) do { _Pragma("unroll") for (int n = 0; n < 2; ++n) _Pragma("unroll") for (int k = 0; k < 2; ++k) dst[n][k] = *(const PG8_LAS bf16x8*)(lds + PG8_SB(b, h) + boff + n * 2048 + k * 1024); } while (0)
#ifndef PG8_PRIO
#define PG8_PRIO 1
#endif
#ifndef PG8_DMA_AUX
#define PG8_DMA_AUX 1
#endif
#ifndef PG8_OPQ
#define PG8_OPQ 0
#endif
#define PG8_MMA(ai, bj, At, Bt) do { if (PG8_PRIO) __builtin_amdgcn_s_setprio(PG8_PRIO); _Pragma("unroll") for (int m = 0; m < 4; ++m) _Pragma("unroll") for (int n = 0; n < 2; ++n) _Pragma("unroll") for (int k = 0; k < 2; ++k) \
        acc[ai][bj][m][n] = __builtin_amdgcn_mfma_f32_16x16x32_bf16(Bt[n][k], At[m][k], acc[ai][bj][m][n], 0, 0, 0); if (PG8_PRIO) __builtin_amdgcn_s_setprio(0); } while (0)
#define PG8_WAIT_V(n) asm volatile("s_waitcnt vmcnt(" #n ")" ::: "memory")
#define PG8_WAIT_L(n) asm volatile("s_waitcnt lgkmcnt(" #n ")" ::: "memory")
#define PG8_BAR __builtin_amdgcn_s_barrier()
#define PG8_SCHED __builtin_amdgcn_sched_barrier(0)
    Unit cur, nxt; int ui = 0;
    if (!S.next(0, cur)) return;
    f32x4 acc[2][2][4][2];
#pragma unroll
    for (int a = 0; a < 2; ++a)
#pragma unroll
        for (int b = 0; b < 2; ++b)
#pragma unroll
            for (int m = 0; m < 4; ++m)
#pragma unroll
                for (int n = 0; n < 2; ++n) acc[a][b][m][n] = (f32x4){0.f, 0.f, 0.f, 0.f};
    bf16x8 At[4][2], B0[2][2], B1[2][2];
    const char* cA = (const char*)g.A + (size_t)cur.pm * tstep + (size_t)(cur.pm >> 4) * (size_t)g.apad; const char* cB = (const char*)g.Bt + (size_t)cur.pn * tstep;
    S.a_ready(cur);
    if constexpr (SP2) {
        PG8_STAGE(PG8_SB(0, 0), cB, voffB); PG8_STAGE(PG8_SB(0, 1), cB + hstep, voffB); PG8_STAGE(PG8_SA(0, 0), cA, voffA); PG8_STAGE(PG8_SA(0, 1), cA + hstep, voffA);
        if (wr == 1) PG8_BAR;
        PG8_WAIT_V(2); PG8_BAR;
        PG8_STAGE(PG8_SB(1, 0), cB + kstep, voffB); PG8_STAGE(PG8_SB(1, 1), cB + hstep + kstep, voffB);
        PG8_WAIT_V(4); PG8_BAR;
    } else {
        PG8_STAGE(PG8_SB(0, 0), cB, voffB); PG8_STAGE(PG8_SA(0, 0), cA, voffA); PG8_STAGE(PG8_SB(0, 1), cB + hstep, voffB); PG8_STAGE(PG8_SA(0, 1), cA + hstep, voffA);
        if (wr == 1) PG8_BAR;
        PG8_WAIT_V(4); PG8_BAR;
        PG8_STAGE(PG8_SB(1, 0), cB + kstep, voffB); PG8_STAGE(PG8_SA(1, 0), cA + kstep, voffA); PG8_STAGE(PG8_SB(1, 1), cB + hstep + kstep, voffB);
        PG8_WAIT_V(6); PG8_BAR;
    }
    for (;;) {
        const bool has_next = S.next(ui + 1, nxt);
        const char* nA = has_next ? (const char*)g.A + (size_t)nxt.pm * tstep + (size_t)(nxt.pm >> 4) * (size_t)g.apad : cA; const char* nB = has_next ? (const char*)g.Bt + (size_t)nxt.pn * tstep : cB;
        for (int t = 0; t < nt; t += 2) {
            const bool last = (t == nt - 2);
            const char* a1 = cA + (size_t)(t + 1) * kstep;
            const char* a2 = last ? nA : cA + (size_t)(t + 2) * kstep; const char* b2 = last ? nB : cB + (size_t)(t + 2) * kstep;
            const char* a3 = a2 + kstep; const char* b3 = b2 + kstep;
            if (last && has_next) S.a_ready(nxt);
            if constexpr (SP2) {
            PG8_LDB(B0, 0, 0); PG8_LDB(B1, 0, 1); PG8_SCHED; PG8_LDA(At, 0, 0); PG8_STAGE(PG8_SA(1, 0), a1, voffA); PG8_STAGE(PG8_SA(1, 1), a1 + hstep, voffA);
            PG8_WAIT_V(8); PG8_WAIT_L(0); PG8_BAR; PG8_MMA(0, 0, At, B0); PG8_MMA(0, 1, At, B1); PG8_BAR; PG8_SCHED;
            PG8_LDA(At, 0, 1); PG8_STAGE(PG8_SB(0, 0), b2, voffB); PG8_STAGE(PG8_SB(0, 1), b2 + hstep, voffB);
            PG8_WAIT_V(6); PG8_WAIT_L(0); PG8_BAR; PG8_MMA(1, 0, At, B0); PG8_MMA(1, 1, At, B1); PG8_BAR; PG8_SCHED;
            PG8_LDB(B0, 1, 0); PG8_LDB(B1, 1, 1); PG8_SCHED; PG8_LDA(At, 1, 0); PG8_STAGE(PG8_SA(0, 0), a2, voffA); PG8_STAGE(PG8_SA(0, 1), a2 + hstep, voffA);
            PG8_WAIT_V(8); PG8_WAIT_L(0); PG8_BAR; PG8_MMA(0, 0, At, B0); PG8_MMA(0, 1, At, B1); PG8_BAR; PG8_SCHED;
            PG8_LDA(At, 1, 1); PG8_STAGE(PG8_SB(1, 0), b3, voffB); PG8_STAGE(PG8_SB(1, 1), b3 + hstep, voffB);
            PG8_WAIT_V(6); PG8_WAIT_L(0); PG8_BAR; PG8_MMA(1, 0, At, B0); PG8_MMA(1, 1, At, B1); PG8_BAR; PG8_SCHED;
            } else {
            PG8_LDB(B0, 0, 0); PG8_SCHED; PG8_LDA(At, 0, 0); PG8_STAGE(PG8_SA(1, 1), a1 + hstep, voffA);
            PG8_WAIT_L(8); PG8_BAR; PG8_WAIT_L(0); PG8_MMA(0, 0, At, B0); PG8_BAR; PG8_SCHED;
            PG8_LDB(B1, 0, 1); PG8_STAGE(PG8_SB(0, 0), b2, voffB);
            PG8_BAR; PG8_WAIT_L(0); PG8_MMA(0, 1, At, B1); PG8_BAR;
            PG8_LDA(At, 0, 1); PG8_STAGE(PG8_SA(0, 0), a2, voffA);
            PG8_BAR; PG8_WAIT_L(0); PG8_MMA(1, 0, At, B0); PG8_BAR; PG8_SCHED;
            PG8_STAGE(PG8_SB(0, 1), b2 + hstep, voffB);
            PG8_WAIT_V(6); PG8_BAR; PG8_MMA(1, 1, At, B1); PG8_BAR;
            PG8_LDB(B0, 1, 0); PG8_SCHED; PG8_LDA(At, 1, 0); PG8_STAGE(PG8_SA(0, 1), a2 + hstep, voffA);
            PG8_WAIT_L(8); PG8_BAR; PG8_WAIT_L(0); PG8_MMA(0, 0, At, B0); PG8_BAR; PG8_SCHED;
            PG8_LDB(B1, 1, 1); PG8_STAGE(PG8_SB(1, 0), b3, voffB);
            PG8_BAR; PG8_WAIT_L(0); PG8_MMA(0, 1, At, B1); PG8_BAR;
            PG8_LDA(At, 1, 1); PG8_STAGE(PG8_SA(1, 0), a3, voffA);
            PG8_BAR; PG8_WAIT_L(0); PG8_MMA(1, 0, At, B0); PG8_BAR; PG8_SCHED;
            PG8_STAGE(PG8_SB(1, 1), b3 + hstep, voffB);
            PG8_WAIT_V(6); PG8_BAR; PG8_MMA(1, 1, At, B1); PG8_BAR;
            }
        }
        if constexpr (ALIGN_EPI) { if (wr == 0) PG8_BAR; }
        if constexpr (Epi::INLOOP_LDS) { static_assert(ALIGN_EPI, "an in-loop epilogue with workgroup barriers needs both halves aligned"); E.fused(acc, cur, wr, wc, fr, fq, epi_lds, wid, lane); S.done(cur); }
        else if constexpr (!Epi::AFTER_DRAIN) { E(acc, cur, wr, wc, fr, fq); S.done(cur); }
        if (!has_next) break;
#pragma unroll
        for (int a = 0; a < 2; ++a)
#pragma unroll
            for (int b = 0; b < 2; ++b)
#pragma unroll
                for (int m = 0; m < 4; ++m)
#pragma unroll
                    for (int n = 0; n < 2; ++n) acc[a][b][m][n] = (f32x4){0.f, 0.f, 0.f, 0.f};
        cur = nxt; cA = nA; cB = nB; ++ui;
        if constexpr (ALIGN_EPI) { if (wr == 1) PG8_BAR; }
    }
    PG8_WAIT_V(0);
    if constexpr (!ALIGN_EPI) { if (wr == 0) PG8_BAR; }
    PG8_BAR;
    if constexpr (Epi::AFTER_DRAIN) { E.fused(acc, cur, wr, wc, fr, fq, lds, wid, lane); S.done(cur); }
#undef PG8_SA
#undef PG8_SB
#undef PG8_STAGE
#undef PG8_LDA
#undef PG8_LDB
#undef PG8_MMA
#undef PG8_WAIT_V
#undef PG8_WAIT_L
#undef PG8_BAR
#undef PG8_SCHED
}
}

#ifndef PG8_SP2
#define PG8_SP2 true
#endif
#ifndef PG8_ALIGN
#define PG8_ALIGN true
#endif
#include <hip/hip_bf16.h>
#include <cmath>
namespace attn_body {
using bf16=__hip_bfloat16;
using bf16x8=__attribute__((ext_vector_type(8)))short;
using s16x4=__attribute__((ext_vector_type(4)))short;
using f32x16=__attribute__((ext_vector_type(16)))float;
using f32x4=__attribute__((ext_vector_type(4)))float;
using u32x4=__attribute__((ext_vector_type(4)))unsigned;
constexpr int SEQ=2048,D=64,DMQ=3072,DMO=1024;
constexpr int NW=8,QBLK=32,QB=QBLK*NW,KVBLK=64,NQB=SEQ/QB;
__device__ __forceinline__ int crow(int r,int hi){return (r&3)+8*(r>>2)+4*hi;}
#define SBAR() __builtin_amdgcn_sched_barrier(0)
__device__ __forceinline__ void cmask(f32x16&p0,f32x16&p1,int jb,int qrel,int hi){
  const float NEG=-INFINITY; int kb=64*jb+4*hi;
  #pragma unroll
  for(int r=0;r<16;++r){int kv=kb+(r&3)+8*(r>>2); if(kv>qrel)p0[r]=NEG; if(kv+32>qrel)p1[r]=NEG;}
}

constexpr int NSLOT=3, SLOTB=8192;
constexpr int LDS_K=0, LDS_V=NSLOT*SLOTB, LDS_WS=2*NSLOT*SLOTB, LDS_OST=LDS_WS+NW*64*4, LDS_BIAS=LDS_OST+NW*4096+2048, LDS_SCAN=LDS_BIAS+SEQ*4, LDS_BYTES=LDS_SCAN+256;
constexpr float C2=0.125f*1.4426950408889634f;
#ifndef ATTN_DMA_CPOL
#define ATTN_DMA_CPOL ""
#endif
__device__ __forceinline__ void glds16(const void*gsrc,unsigned lds_dst){unsigned keep;
  asm volatile("s_mov_b32 %0, m0\n\ts_mov_b32 m0, %2\n\ts_nop 0\n\tglobal_load_lds_dwordx4 %1, off" ATTN_DMA_CPOL "\n\ts_mov_b32 m0, %0":"=&s"(keep):"v"(gsrc),"s"(lds_dst):"memory");}
__device__ __forceinline__ float max3f(float a,float b,float c){float r;asm("v_max3_f32 %0, %1, %2, %3":"=v"(r):"v"(a),"v"(b),"v"(c));return r;}
__device__ __forceinline__ float max2f(float a,float b){float r;asm("v_max_f32_e32 %0, %1, %2":"=v"(r):"v"(a),"v"(b));return r;}
__device__ __forceinline__ float fadd_s(float a,float b){float r;asm("v_add_f32_e32 %0, %1, %2":"=v"(r):"v"(a),"v"(b));return r;}
__device__ __forceinline__ float fsub_s(float a,float b){float r;asm("v_sub_f32_e32 %0, %1, %2":"=v"(r):"v"(a),"v"(b));return r;}
typedef float f32x2_t __attribute__((ext_vector_type(2))); typedef __bf16 bf16x2_t __attribute__((ext_vector_type(2)));
__device__ __forceinline__ unsigned cvtpk_s(float lo,float hi){f32x2_t v={lo,hi};bf16x2_t b=__builtin_convertvector(v,bf16x2_t);return __builtin_bit_cast(unsigned,b);}
#define WAIT_BAR(N) asm volatile("s_waitcnt vmcnt(" #N ") lgkmcnt(0)\n\ts_barrier":::"memory")

__device__ __forceinline__ void qkt(f32x16&p0,f32x16&p1,const char*Kslot,const bf16x8*qr,const f32x16&negm,int r32,int hi){
  const char*kb=Kslot+hi*512+r32*16;
  #pragma unroll
  for(int d0=0;d0<4;++d0){
    const bf16x8 b0=*reinterpret_cast<const bf16x8*>(kb+d0*2048);
    const bf16x8 b1=*reinterpret_cast<const bf16x8*>(kb+d0*2048+1024);
    if(d0==0){p0=__builtin_amdgcn_mfma_f32_32x32x16_bf16(b0,qr[0],negm,0,0,0);p1=__builtin_amdgcn_mfma_f32_32x32x16_bf16(b1,qr[0],negm,0,0,0);}
    else{p0=__builtin_amdgcn_mfma_f32_32x32x16_bf16(b0,qr[d0],p0,0,0,0);p1=__builtin_amdgcn_mfma_f32_32x32x16_bf16(b1,qr[d0],p1,0,0,0);}}
}
typedef __attribute__((address_space(3))) const char* lds_cptr;
typedef short v4i16_t __attribute__((ext_vector_type(4)));
__device__ __forceinline__ void kload8(bf16x8*kf,lds_cptr kp){
  kf[0]=*(const __attribute__((address_space(3))) bf16x8*)(kp);      kf[1]=*(const __attribute__((address_space(3))) bf16x8*)(kp+1024);
  kf[2]=*(const __attribute__((address_space(3))) bf16x8*)(kp+2048); kf[3]=*(const __attribute__((address_space(3))) bf16x8*)(kp+3072);
  kf[4]=*(const __attribute__((address_space(3))) bf16x8*)(kp+4096); kf[5]=*(const __attribute__((address_space(3))) bf16x8*)(kp+5120);
  kf[6]=*(const __attribute__((address_space(3))) bf16x8*)(kp+6144); kf[7]=*(const __attribute__((address_space(3))) bf16x8*)(kp+7168);
}
__device__ __forceinline__ void kload2(bf16x8*kf,lds_cptr kp,int j){ kf[2*j]=*(const __attribute__((address_space(3))) bf16x8*)(kp+j*2048); kf[2*j+1]=*(const __attribute__((address_space(3))) bf16x8*)(kp+j*2048+1024); }
__device__ __forceinline__ s16x4 vtr(lds_cptr p){ return __builtin_bit_cast(s16x4,__builtin_amdgcn_ds_read_tr16_b64_v4i16((__attribute__((address_space(3))) v4i16_t*)p)); }
__device__ __forceinline__ float rowmax(const f32x16&p0,const f32x16&p1){
  float a=max3f(p0[0],p0[1],p1[0]),b=max3f(p0[2],p0[3],p1[1]);a=max3f(a,p1[2],p1[3]);
  #pragma unroll
  for(int r=4;r<16;r+=4){a=max3f(a,p0[r],p0[r+1]);b=max3f(b,p0[r+2],p0[r+3]);a=max3f(a,p1[r],p1[r+1]);b=max3f(b,p1[r+2],p1[r+3]);}
  const float m=max2f(a,b);
  auto rr=__builtin_amdgcn_permlane32_swap(__float_as_uint(m),__float_as_uint(m),false,false);
  return max2f(__uint_as_float(rr[0]),__uint_as_float(rr[1]));
}
__device__ __forceinline__ void pv(f32x16*o,int vb,bf16x8 pa0,bf16x8 pa1,bf16x8 pa2,bf16x8 pa3){
  #pragma unroll
  for(int d0=0;d0<2;++d0){s16x4 lo[4],hi[4];
    #pragma unroll
    for(int ks=0;ks<4;++ks){
      asm volatile("ds_read_b64_tr_b16 %0,%1 offset:%c2":"=&v"(lo[ks]):"v"(vb),"i"(d0*4096+ks*1024):"memory");
      asm volatile("ds_read_b64_tr_b16 %0,%1 offset:%c2":"=&v"(hi[ks]):"v"(vb),"i"(d0*4096+ks*1024+512):"memory");}
    asm volatile("s_waitcnt lgkmcnt(0)":::"memory");SBAR();
    #define PK(k) (bf16x8){lo[k][0],lo[k][1],lo[k][2],lo[k][3],hi[k][0],hi[k][1],hi[k][2],hi[k][3]}
    o[d0]=__builtin_amdgcn_mfma_f32_32x32x16_bf16(pa0,PK(0),o[d0],0,0,0);
    o[d0]=__builtin_amdgcn_mfma_f32_32x32x16_bf16(pa1,PK(1),o[d0],0,0,0);
    o[d0]=__builtin_amdgcn_mfma_f32_32x32x16_bf16(pa2,PK(2),o[d0],0,0,0);
    o[d0]=__builtin_amdgcn_mfma_f32_32x32x16_bf16(pa3,PK(3),o[d0],0,0,0);
    #undef PK
  }
}

__device__ __forceinline__ void fox_bias_table(const float*lf,int q0A,int q0B,int q0C,int q0D,char*shm,const int wave_id,const float thr,int&skA,int&skB,int&skC,int&skD){
  const int wid=opaque_s(wave_id),lane=lane_id(),tid=wid*64+lane;
  unsigned lb_=(unsigned)(uintptr_t)shm; asm volatile("":"+v"(lb_));
  typedef __attribute__((address_space(3))) float lf32; typedef __attribute__((address_space(3))) f32x4 lf32x4;
  lf32*tab=(lf32*)(lb_+LDS_BIAS); lf32*wt=(lf32*)(lb_+LDS_SCAN);
  const f32x4 a4_=*(const f32x4*)(lf+4*tid); const float a0=a4_[0],a1=a4_[1],a2=a4_[2],a3=a4_[3];
  const float p1=a0+a1,p2=p1+a2,p3=p2+a3;
  float w=p3;
  #pragma unroll
  for(int o=1;o<64;o<<=1){const float t=shfl_idx_l(w,lane-o); if(lane>=o)w+=t;}
  if(lane==63)wt[wid]=w;
  asm volatile("s_waitcnt lgkmcnt(0)\n\ts_barrier":::"memory");
  float off=0.f;
  #pragma unroll
  for(int j=0;j<8;++j){const float x=wt[j]; if(j<wid)off+=x;}
  const float ex=off+(w-p3);
  const float c0=ex+a0,c1=ex+p1,c2=ex+p2,c3=ex+p3;
  if(4*tid==q0A)wt[8]=c0;
  if(4*tid==q0B)wt[9]=c0;
  if(4*tid==q0C)wt[10]=c0;
  if(4*tid==q0D)wt[11]=c0;
  if((tid&15)==15)wt[16+(tid>>4)]=c3;
  const float L2E=1.4426950408889634f;
  *(lf32x4*)(tab+4*tid)=(f32x4){c0*L2E,c1*L2E,c2*L2E,c3*L2E};
  asm volatile("s_waitcnt lgkmcnt(0)\n\ts_barrier":::"memory");
  const float refA=wt[8],refB=wt[9],refC=wt[10],refD=wt[11];
  int cA=0,cB=0,cC=0,cD=0;
  #pragma unroll
  for(int g=0;g<8;++g){const f32x4 e=*(lf32x4*)(wt+16+4*g);
    #pragma unroll
    for(int i=0;i<4;++i){ if(64*(4*g+i)<q0A&&(e[i]-refA)*L2E>=thr)++cA; if(64*(4*g+i)<q0B&&(e[i]-refB)*L2E>=thr)++cB; if(64*(4*g+i)<q0C&&(e[i]-refC)*L2E>=thr)++cC; if(64*(4*g+i)<q0D&&(e[i]-refD)*L2E>=thr)++cD; } }
  skA=__builtin_amdgcn_readfirstlane(cA&~1); skB=__builtin_amdgcn_readfirstlane(cB&~1); skC=__builtin_amdgcn_readfirstlane(cC&~1); skD=__builtin_amdgcn_readfirstlane(cD&~1);
}

template<int THRL,bool BIAS> __device__ __forceinline__ void attn_unit(int qb,int tskip,const bf16*Qh,const bf16*__restrict__ Kh,const bf16*__restrict__ Vh,bf16*Oh,int mode,float*scr,int sub,float lam,const float*gsub,char*shm,const int wave_id,const bool pre,const bool has_next,const bf16*nKh,const bf16*nVh){
  const int wid=opaque_s(wave_id),lane=lane_id(),r32=lane&31,hi=lane>>5;
  const int q0=qb*QB;
  const bf16*Qw=Qh+(long)(q0+wid*QBLK)*DMQ;
  const unsigned lds0=(unsigned)(uintptr_t)shm;
  float*wsf=(float*)(shm+LDS_WS)+wid*64;
  const bf16*ksrc=Kh+(long)(tskip*KVBLK+(wid&1)*32+(lane&31))*DMQ+((wid>>1)*2+(lane>>5))*8;
  const bf16*vsrc=Vh+(long)(tskip*KVBLK+16*(wid&3)+(lane>>2))*DMQ+(wid>>2)*32+(lane&3)*8;
  const unsigned kdst=lds0+LDS_K+wid*1024, vdst=lds0+LDS_V+wid*1024;
  #define DMA_K(t,slot) glds16(ksrc+(long)(t)*KVBLK*DMQ,(unsigned)__builtin_amdgcn_readfirstlane(kdst+(slot)))
  #define DMA_V(t,slot) glds16(vsrc+(long)(t)*KVBLK*DMQ,(unsigned)__builtin_amdgcn_readfirstlane(vdst+(slot)))
  const int vb0=(int)(lds0+LDS_V)+((lane>>4)&1)*32+(lane&3)*8+(4*hi+((lane&15)>>2))*64;
  const char*Kbase=shm+LDS_K; bf16x8 kf[8];
  const lds_cptr shm3=(lds_cptr)shm; const lds_cptr kp0=shm3+LDS_K+hi*512+r32*16; const lds_cptr vp0=shm3+LDS_V+((lane>>4)&1)*32+(lane&3)*8+(4*hi+((lane&15)>>2))*64;
  const __attribute__((address_space(3))) float* blp=(const __attribute__((address_space(3))) float*)(shm3+LDS_BIAS)+tskip*KVBLK+4*hi;
  const int NT=(q0+QB)/KVBLK-tskip;
  if(!pre){DMA_K(0,0);DMA_V(0,0);DMA_K(1,SLOTB);}
  bf16x8 qr[4];
  #pragma unroll
  for(int d0=0;d0<4;++d0)qr[d0]=*reinterpret_cast<const bf16x8*>(&Qw[(long)r32*DMQ+d0*16+hi*8]);
  float mhat=0.f,l_reg=0.f;f32x16 o[2];o[0]=f32x16{};o[1]=f32x16{};float z0_=0.f;asm volatile("":"+v"(z0_));f32x16 negm;
  #pragma unroll
  for(int r=0;r<16;++r)negm[r]=z0_;
  asm volatile("":"+v"(negm));
  const int qrel=wid*QBLK+r32;
  #define CMASK(P0,P1,t) do{int jb_=(t)-(NT-4); if(jb_>=0)cmask(P0,P1,jb_,qrel,hi);}while(0)
  #define BIASADD(C0,C1,t) do{ if(BIAS){ const __attribute__((address_space(3))) f32x4* bp_=(const __attribute__((address_space(3))) f32x4*)(blp+(t)*64); \
    _Pragma("unroll") for(int g_=0;g_<4;++g_){ const f32x4 b0_=bp_[2*g_], b1_=bp_[8+2*g_]; \
      C0[4*g_+0]-=b0_[0]; C0[4*g_+1]-=b0_[1]; C0[4*g_+2]-=b0_[2]; C0[4*g_+3]-=b0_[3]; \
      C1[4*g_+0]-=b1_[0]; C1[4*g_+1]-=b1_[1]; C1[4*g_+2]-=b1_[2]; C1[4*g_+3]-=b1_[3]; } } }while(0)
  bool resc=false;
  #define START(P0,P1) do{ const float rm=rowmax(P0,P1); resc=false; \
    { const float dl=rm; mhat=fadd_s(mhat,dl); \
      _Pragma("unroll") for(int r=0;r<16;++r){P0[r]=fsub_s(P0[r],dl);P1[r]=fsub_s(P1[r],dl);} \
      _Pragma("unroll") for(int r=0;r<16;++r)negm[r]=-mhat; asm volatile("":"+v"(negm)); } \
    _Pragma("unroll") for(int r=0;r<16;++r)P0[r]=__builtin_amdgcn_exp2f(P0[r]); }while(0)
  #define RESC() do{ if(resc){ asm volatile("s_waitcnt lgkmcnt(0)":::"memory"); \
      _Pragma("unroll") for(int d_=0;d_<2;++d_) _Pragma("unroll") for(int r=0;r<16;++r)o[d_][r]*=wsf[crow(r,hi)]; } }while(0)
  f32x16 pA0,pA1,pB0,pB1;
  int sl_prev=0,sl_cur=0,sl_next=SLOTB;
  #define ROT() do{sl_prev=sl_cur;sl_cur=sl_next;sl_next=(sl_next==(NSLOT-1)*SLOTB)?0:sl_next+SLOTB;}while(0)
  if(!pre){ DMA_K(2,2*SLOTB);
    WAIT_BAR(3); }
  else { WAIT_BAR(0); }
  qkt(pA0,pA1,Kbase,qr,negm,r32,hi);asm volatile("s_nop 15\n\ts_nop 7":"+v"(pA0),"+v"(pA1));BIASADD(pA0,pA1,0);CMASK(pA0,pA1,0);
  START(pA0,pA1);
  _Pragma("unroll") for(int r=0;r<16;++r)pA1[r]=__builtin_amdgcn_exp2f(pA1[r]);
  WAIT_BAR(0);
  DMA_K(3,0);DMA_V(1,SLOTB);
  ROT();
  kload8(kf,kp0+sl_cur);
  WAIT_BAR(2);
  s16x4 vlo[8],vhi[8]; u32x4 pw0,pw1,pw2,pw3;
  #define PKW(P,B) cvtpk_s(P[B],P[B+1])
  #define PAF(k) __builtin_bit_cast(bf16x8,pw##k)
  #define VFR(i) (bf16x8){vlo[i][0],vlo[i][1],vlo[i][2],vlo[i][3],vhi[i][0],vhi[i][1],vhi[i][2],vhi[i][3]}
  #define PIN(x) asm volatile("":"+v"(x))
  #define MX3(a,b,c) __builtin_fmaxf(__builtin_fmaxf((a),(b)),(c))
  #define GAPA(MF,A0,A1,A2,A3,W0,W1,PW) do{ MF; sacc+=A0; sacc+=A1; sacc+=A2; sacc+=A3; PIN(sacc); W0; W1; PIN(PW); SBAR(); }while(0)
  #define EX(v) __builtin_amdgcn_exp2f(v)
  #define GAPB(MF,X,B) do{ MF; X[B]=EX(X[B]); X[B+1]=EX(X[B+1]); X[B+2]=EX(X[B+2]); X[B+3]=EX(X[B+3]); PIN(X); SBAR(); }while(0)
  #define VRD(i) do{ vlo[i]=vtr(vp_+(((i)>>2)*4096+((i)&3)*1024)); vhi[i]=vtr(vp_+(((i)>>2)*4096+((i)&3)*1024+512)); }while(0)
  #define KRD(G,j) do{ if(G){ kload2(kf,kp0+sl_next,j); SBAR(); } }while(0)
  #define STEP(C0,C1,P0,P1,t,GK,GV,GL) do{ SBAR(); \
    const lds_cptr vp_=vp0+sl_prev; \
    VRD(0); SBAR(); float sacc=(P0[0]+P0[1]); \
    GAPA(C0=__builtin_amdgcn_mfma_f32_32x32x16_bf16(kf[0],qr[0],negm,0,0,0), P0[2],P0[3],P0[4],P0[5],     pw0[0]=PKW(P0,0), pw0[1]=PKW(P0,2), pw0); \
    VRD(4); SBAR(); GAPA(C1=__builtin_amdgcn_mfma_f32_32x32x16_bf16(kf[1],qr[0],negm,0,0,0), P0[6],P0[7],P0[8],P0[9],     pw0[2]=PKW(P0,4), pw0[3]=PKW(P0,6), pw0); \
    VRD(1); SBAR(); GAPA(C0=__builtin_amdgcn_mfma_f32_32x32x16_bf16(kf[2],qr[1],C0,0,0,0),   P0[10],P0[11],P0[12],P0[13], pw1[0]=PKW(P0,8), pw1[1]=PKW(P0,10), pw1); \
    VRD(5); SBAR(); GAPA(C1=__builtin_amdgcn_mfma_f32_32x32x16_bf16(kf[3],qr[1],C1,0,0,0),   P0[14],P0[15],P1[0],P1[1],   pw1[2]=PKW(P0,12),pw1[3]=PKW(P0,14), pw1); \
    VRD(2); SBAR(); GAPA(C0=__builtin_amdgcn_mfma_f32_32x32x16_bf16(kf[4],qr[2],C0,0,0,0),   P1[2],P1[3],P1[4],P1[5],     pw2[0]=PKW(P1,0), pw2[1]=PKW(P1,2), pw2); \
    VRD(6); SBAR(); GAPA(C1=__builtin_amdgcn_mfma_f32_32x32x16_bf16(kf[5],qr[2],C1,0,0,0),   P1[6],P1[7],P1[8],P1[9],     pw2[2]=PKW(P1,4), pw2[3]=PKW(P1,6), pw2); \
    VRD(3); SBAR(); GAPA(C0=__builtin_amdgcn_mfma_f32_32x32x16_bf16(kf[6],qr[3],C0,0,0,0),   P1[10],P1[11],P1[12],P1[13], pw3[0]=PKW(P1,8), pw3[1]=PKW(P1,10), pw3); \
    VRD(7); SBAR(); GAPA(C1=__builtin_amdgcn_mfma_f32_32x32x16_bf16(kf[7],qr[3],C1,0,0,0),   P1[14],P1[15],0.f,0.f,       pw3[2]=PKW(P1,12),pw3[3]=PKW(P1,14), pw3); \
    l_reg+=sacc; \
    if(GK){DMA_K((t)+3,sl_cur);} if(GV){DMA_V((t)+1,sl_next);} \
    BIASADD(C0,C1,t); \
    CMASK(C0,C1,t); \
    { float a=MX3(C0[0],C0[1],C1[0]),b=MX3(C0[2],C0[3],C1[1]); a=MX3(a,C1[2],C1[3]); \
      _Pragma("unroll") for(int r=4;r<16;r+=4){a=MX3(a,C0[r],C0[r+1]);b=MX3(b,C0[r+2],C0[r+3]);a=MX3(a,C1[r],C1[r+1]);b=MX3(b,C1[r+2],C1[r+3]);} \
      float rm=__builtin_fmaxf(a,b); { auto rr=__builtin_amdgcn_permlane32_swap(__float_as_uint(rm),__float_as_uint(rm),false,false); rm=__builtin_fmaxf(__uint_as_float(rr[0]),__uint_as_float(rr[1])); } \
      resc=false; \
      if(__builtin_expect(__any(rm>(float)THRL),0)){ const float dl=__builtin_fmaxf(rm,0.f); mhat+=dl; \
        _Pragma("unroll") for(int r=0;r<16;++r){C0[r]-=dl;C1[r]-=dl;} \
        _Pragma("unroll") for(int r=0;r<16;++r)negm[r]=-mhat; asm volatile("":"+v"(negm)); \
        const float f=__builtin_amdgcn_exp2f(-dl); l_reg*=f; if(hi==0)wsf[r32]=f; resc=true; } } \
    SBAR(); \
    GAPB(o[0]=__builtin_amdgcn_mfma_f32_32x32x16_bf16(PAF(0),VFR(0),o[0],0,0,0), C0,0); \
    GAPB(o[1]=__builtin_amdgcn_mfma_f32_32x32x16_bf16(PAF(0),VFR(4),o[1],0,0,0), C0,4); \
    KRD(GL,0); GAPB(o[0]=__builtin_amdgcn_mfma_f32_32x32x16_bf16(PAF(1),VFR(1),o[0],0,0,0), C0,8); \
    KRD(GL,1); GAPB(o[1]=__builtin_amdgcn_mfma_f32_32x32x16_bf16(PAF(1),VFR(5),o[1],0,0,0), C0,12); \
    KRD(GL,2); GAPB(o[0]=__builtin_amdgcn_mfma_f32_32x32x16_bf16(PAF(2),VFR(2),o[0],0,0,0), C1,0); \
    KRD(GL,3); GAPB(o[1]=__builtin_amdgcn_mfma_f32_32x32x16_bf16(PAF(2),VFR(6),o[1],0,0,0), C1,4); \
    GAPB(o[0]=__builtin_amdgcn_mfma_f32_32x32x16_bf16(PAF(3),VFR(3),o[0],0,0,0), C1,8); \
    GAPB(o[1]=__builtin_amdgcn_mfma_f32_32x32x16_bf16(PAF(3),VFR(7),o[1],0,0,0), C1,12); \
    }while(0)
  int t=1;
  #undef CMASK
  #define CMASK(P0,P1,t) do{}while(0)
  for(;t+5<NT;t+=2){
    STEP(pB0,pB1,pA0,pA1,t,true,true,true);     WAIT_BAR(2); RESC(); ROT();
    STEP(pA0,pA1,pB0,pB1,t+1,true,true,true);   WAIT_BAR(2); RESC(); ROT();
  }
  #undef CMASK
  #define CMASK(P0,P1,t) do{int jb_=(t)-(NT-4); if(jb_>=0)cmask(P0,P1,jb_,qrel,hi);}while(0)
  #define ENDW(tt) do{ if((tt)+3<NT){WAIT_BAR(2);} else if((tt)+2<NT){WAIT_BAR(1);} else {WAIT_BAR(0);} }while(0)
  for(;t+1<NT;t+=2){
    STEP(pB0,pB1,pA0,pA1,t,(t+3<NT),(t+1<NT),(t+1<NT));       ENDW(t);   RESC(); ROT();
    STEP(pA0,pA1,pB0,pB1,t+1,(t+4<NT),(t+2<NT),(t+2<NT));     ENDW(t+1); RESC(); ROT();
  }
  STEP(pB0,pB1,pA0,pA1,NT-1,false,false,false); RESC();
  { float sacc=pB0[0]+pB0[1]; _Pragma("unroll") for(int r=2;r<16;++r)sacc+=pB0[r]; _Pragma("unroll") for(int r=0;r<16;++r)sacc+=pB1[r]; l_reg+=sacc;
    pw0=(u32x4){PKW(pB0,0),PKW(pB0,2),PKW(pB0,4),PKW(pB0,6)};pw1=(u32x4){PKW(pB0,8),PKW(pB0,10),PKW(pB0,12),PKW(pB0,14)};pw2=(u32x4){PKW(pB1,0),PKW(pB1,2),PKW(pB1,4),PKW(pB1,6)};pw3=(u32x4){PKW(pB1,8),PKW(pB1,10),PKW(pB1,12),PKW(pB1,14)};
    SBAR(); pv(o,vb0+sl_cur,PAF(0),PAF(1),PAF(2),PAF(3)); }
  #undef PKW
  #undef PAF
  #undef VFR
  #undef PIN
  #undef MX3
  #undef GAPA
  #undef GAPB
  #undef EX
  #undef VRD
  #undef KRD
  #undef STEP
  #undef ENDW
  asm volatile("s_waitcnt lgkmcnt(0)\n\ts_barrier":::"memory");
  if(has_next){ const bf16*nk=nKh+(long)((wid&1)*32+(lane&31))*DMQ+((wid>>1)*2+(lane>>5))*8; const bf16*nv=nVh+(long)(16*(wid&3)+(lane>>2))*DMQ+(wid>>2)*32+(lane&3)*8;
    glds16(nk,(unsigned)__builtin_amdgcn_readfirstlane(kdst)); glds16(nv,(unsigned)__builtin_amdgcn_readfirstlane(vdst));
    glds16(nk+(long)KVBLK*DMQ,(unsigned)__builtin_amdgcn_readfirstlane(kdst+SLOTB)); glds16(nk+(long)2*KVBLK*DMQ,(unsigned)__builtin_amdgcn_readfirstlane(kdst+2*SLOTB)); }
  {auto rr=__builtin_amdgcn_permlane32_swap(__float_as_uint(l_reg),__float_as_uint(l_reg),false,false);l_reg=__uint_as_float(rr[0])+__uint_as_float(rr[1]);}
  if(hi==0)wsf[32+r32]=l_reg;asm volatile("s_waitcnt lgkmcnt(0)":::"memory");
  #pragma unroll
  for(int r=0;r<16;++r){const float rl=__builtin_amdgcn_rcpf(wsf[32+crow(r,hi)]); o[0][r]*=rl; o[1][r]*=rl;}
  if(mode==1){
    float*sp=scr+((size_t)(sub*NW+wid)*32)*64+lane;
    #pragma unroll
    for(int d0=0;d0<2;++d0)
      #pragma unroll
      for(int r=0;r<16;++r)sp[(d0*16+r)*64]=o[d0][r];
  } else {
    bf16*Ow=Oh+(long)(q0+wid*QBLK)*DMO;
    bf16*stg=(bf16*)(shm+LDS_OST)+wid*2048;
    #define OSTAGE(X,COFF) do{ \
      _Pragma("unroll") for(int r=0;r<16;++r){const int orow=crow(r,hi); \
        _Pragma("unroll") for(int d0=0;d0<2;++d0)stg[orow*64+d0*32+r32]=__float2bfloat16(X[d0][r]);} \
      asm volatile("s_waitcnt lgkmcnt(0)":::"memory"); \
      _Pragma("unroll") for(int i=0;i<4;++i){const int row=i*8+(lane>>3),ch=lane&7; const u32x4 v=*(const u32x4*)(stg+row*64+ch*8); *(u32x4*)(Ow+(long)row*DMO+(COFF)+ch*8)=v;} \
      asm volatile("s_waitcnt lgkmcnt(0)":::"memory"); }while(0)
    if(mode==2){
      asm volatile("s_waitcnt vmcnt(0)":::"memory");
      __builtin_amdgcn_fence(__ATOMIC_ACQUIRE,"agent");
      const float*sp=scr+((size_t)wid*32)*64+lane;
      f32x16 e[2]; float ss[16];
      #pragma unroll
      for(int r=0;r<16;++r)ss[r]=0.f;
      #pragma unroll
      for(int d0=0;d0<2;++d0)
        #pragma unroll
        for(int r=0;r<16;++r){
          const float a1v0=sp[((size_t)(0*NW*32)+d0*16+r)*64],a1v1=sp[((size_t)(1*NW*32)+d0*16+r)*64],a2v0=sp[((size_t)(2*NW*32)+d0*16+r)*64];
          const float x0=a1v0-lam*a2v0,x1=a1v1-lam*o[d0][r]; e[d0][r]=x0; o[d0][r]=x1; ss[r]+=x0*x0+x1*x1; }
      #pragma unroll
      for(int r=0;r<16;++r){
        ss[r]=xsum16(rowsum16(ss[r]));
        ss[r]=1.0f/sqrtf(ss[r]*(1.0f/128.0f)+1e-6f); }
      const float g00=gsub[r32]*0.8f,g01=gsub[32+r32]*0.8f,g10=gsub[64+r32]*0.8f,g11=gsub[96+r32]*0.8f;
      #pragma unroll
      for(int r=0;r<16;++r){e[0][r]*=ss[r]*g00; e[1][r]*=ss[r]*g01; o[0][r]*=ss[r]*g10; o[1][r]*=ss[r]*g11;}
      OSTAGE(e,0); OSTAGE(o,64);
    } else { OSTAGE(o,0); }
    #undef OSTAGE
  }
  if(!has_next) asm volatile("s_waitcnt lgkmcnt(0)\n\ts_barrier":::"memory");
  #undef DMA_K
  #undef DMA_V
  #undef CMASK
  #undef BIASADD
  #undef START
  #undef RESC
  #undef ROT
}

constexpr int V2_LDS_K=0, V2_LDS_V=NSLOT*SLOTB, V2_SLOTV=2*SLOTB, V2_LDS_WS=V2_LDS_V+NSLOT*V2_SLOTV, V2_LDS_OST=V2_LDS_WS+NW*64*4, V2_LDS_BYTES=V2_LDS_OST+NW*4096;
template<int THRL> __device__ __forceinline__ void attn_unit128(int qb,const bf16*Qh,const bf16*__restrict__ Kh,const bf16*__restrict__ Vh,bf16*Oh,int mode,float*scr,float lam,const float*gsub,char*shm,const int wave_id,const bool pre,const bool has_next,const bf16*nKh,const bf16*nVh){
  const int wid=opaque_s(wave_id),lane=lane_id(),r32=lane&31,hi=lane>>5;
  const int q0=qb*QB;
  const bf16*Qw=Qh+(long)(q0+wid*QBLK)*DMQ;
  const unsigned lds0=(unsigned)(uintptr_t)shm;
  float*wsf=(float*)(shm+V2_LDS_WS)+wid*64;
  const bf16*ksrc=Kh+(long)((wid&1)*32+(lane&31))*DMQ+((wid>>1)*2+(lane>>5))*8;
  const bf16*vsrc=Vh+(long)(16*(wid&3)+(lane>>2))*DMQ+(wid>>2)*32+(lane&3)*8;
  const unsigned kdst=lds0+V2_LDS_K+wid*1024, vdst=lds0+V2_LDS_V+wid*1024;
  #define DMA_K(t,slot) glds16(ksrc+(long)(t)*KVBLK*DMQ,(unsigned)__builtin_amdgcn_readfirstlane(kdst+(slot)))
  #define DMA_V(t,slot) do{ glds16(vsrc+(long)(t)*KVBLK*DMQ,(unsigned)__builtin_amdgcn_readfirstlane(vdst+2*(slot))); glds16(vsrc+(long)(t)*KVBLK*DMQ+64,(unsigned)__builtin_amdgcn_readfirstlane(vdst+2*(slot)+SLOTB)); }while(0)
  const int vb0=(int)(lds0+V2_LDS_V)+((lane>>4)&1)*32+(lane&3)*8+(4*hi+((lane&15)>>2))*64;
  const char*Kbase=shm+V2_LDS_K; bf16x8 kf[8];
  const lds_cptr shm3=(lds_cptr)shm; const lds_cptr kp0=shm3+V2_LDS_K+hi*512+r32*16; const lds_cptr vp0=shm3+V2_LDS_V+((lane>>4)&1)*32+(lane&3)*8+(4*hi+((lane&15)>>2))*64;
  const int NT=(q0+QB)/KVBLK;
  if(!pre){DMA_K(0,0);DMA_V(0,0);DMA_K(1,SLOTB);}
  bf16x8 qr[4];
  #pragma unroll
  for(int d0=0;d0<4;++d0)qr[d0]=*reinterpret_cast<const bf16x8*>(&Qw[(long)r32*DMQ+d0*16+hi*8]);
  float mhat=0.f,l_reg=0.f;f32x16 o[4];o[0]=f32x16{};o[1]=f32x16{};o[2]=f32x16{};o[3]=f32x16{};
  const int qrel=wid*QBLK+r32;
  #define CMASK(P0,P1,t) do{int jb_=(t)-(NT-4); if(jb_>=0)cmask(P0,P1,jb_,qrel,hi);}while(0)
  bool resc=false;
  #define RESC() do{ if(resc){ asm volatile("s_waitcnt lgkmcnt(0)":::"memory"); \
      _Pragma("unroll") for(int d_=0;d_<4;++d_) _Pragma("unroll") for(int r=0;r<16;++r)o[d_][r]*=wsf[crow(r,hi)]; } }while(0)
  f32x16 pA0,pA1,pB0,pB1;
  int sl_prev=0,sl_cur=0,sl_next=SLOTB;
  #define ROT() do{sl_prev=sl_cur;sl_cur=sl_next;sl_next=(sl_next==(NSLOT-1)*SLOTB)?0:sl_next+SLOTB;}while(0)
  if(!pre){ DMA_K(2,2*SLOTB);
    WAIT_BAR(4); }
  else { WAIT_BAR(0); }
  { f32x16 z16; float z0_=0.f; asm volatile("":"+v"(z0_));
    #pragma unroll
    for(int r=0;r<16;++r)z16[r]=z0_;
    qkt(pA0,pA1,Kbase,qr,z16,r32,hi); }
  asm volatile("s_nop 15\n\ts_nop 7":"+v"(pA0),"+v"(pA1));
  CMASK(pA0,pA1,0);
  { const float rm=rowmax(pA0,pA1); mhat=rm;
    #pragma unroll
    for(int r=0;r<16;++r){pA0[r]=__builtin_amdgcn_exp2f(pA0[r]-rm);pA1[r]=__builtin_amdgcn_exp2f(pA1[r]-rm);} }
  WAIT_BAR(0);
  DMA_K(3,0);DMA_V(1,SLOTB);
  ROT();
  kload8(kf,kp0+sl_cur);
  WAIT_BAR(3);
  s16x4 vlo[8],vhi[8],wlo[8],whi[8]; u32x4 pw0,pw1,pw2,pw3;
  #define PKW(P,B) cvtpk_s(P[B],P[B+1])
  #define PAF(k) __builtin_bit_cast(bf16x8,pw##k)
  #define VFR(i) (bf16x8){vlo[i][0],vlo[i][1],vlo[i][2],vlo[i][3],vhi[i][0],vhi[i][1],vhi[i][2],vhi[i][3]}
  #define WFR(i) (bf16x8){wlo[i][0],wlo[i][1],wlo[i][2],wlo[i][3],whi[i][0],whi[i][1],whi[i][2],whi[i][3]}
  #define PIN(x) asm volatile("":"+v"(x))
  #define MX3(a,b,c) __builtin_fmaxf(__builtin_fmaxf((a),(b)),(c))
  #define GAPA(MF,A0,A1,A2,A3,W0,W1,PW) do{ MF; sacc+=A0; sacc+=A1; sacc+=A2; sacc+=A3; PIN(sacc); W0; W1; PIN(PW); SBAR(); }while(0)
  #define EX(v) __builtin_amdgcn_exp2f(v)
  #define GAPB(MF,X,B) do{ MF; X[B]=EX(X[B]); X[B+1]=EX(X[B+1]); PIN(X); SBAR(); }while(0)
  #define VRD(i) do{ vlo[i]=vtr(vp_+(((i)>>2)*4096+((i)&3)*1024)); vhi[i]=vtr(vp_+(((i)>>2)*4096+((i)&3)*1024+512)); }while(0)
  #define WRD(i) do{ wlo[i]=vtr(vp_+(8192+((i)>>2)*4096+((i)&3)*1024)); whi[i]=vtr(vp_+(8192+((i)>>2)*4096+((i)&3)*1024+512)); SBAR(); }while(0)
  #define KRD(G,j) do{ if(G){ kload2(kf,kp0+sl_next,j); SBAR(); } }while(0)
  #define STEP(C0,C1,P0,P1,t,GK,GV,GL) do{ SBAR(); \
    const lds_cptr vp_=vp0+2*sl_prev; \
    { const float nm_=-mhat; _Pragma("unroll") for(int r=0;r<16;++r){C0[r]=nm_;C1[r]=nm_;} } PIN(C0); PIN(C1); SBAR(); \
    VRD(0); SBAR(); float sacc=(P0[0]+P0[1]); \
    GAPA(C0=__builtin_amdgcn_mfma_f32_32x32x16_bf16(kf[0],qr[0],C0,0,0,0), P0[2],P0[3],P0[4],P0[5],     pw0[0]=PKW(P0,0), pw0[1]=PKW(P0,2), pw0); \
    VRD(4); SBAR(); GAPA(C1=__builtin_amdgcn_mfma_f32_32x32x16_bf16(kf[1],qr[0],C1,0,0,0), P0[6],P0[7],P0[8],P0[9],     pw0[2]=PKW(P0,4), pw0[3]=PKW(P0,6), pw0); \
    VRD(1); SBAR(); GAPA(C0=__builtin_amdgcn_mfma_f32_32x32x16_bf16(kf[2],qr[1],C0,0,0,0),   P0[10],P0[11],P0[12],P0[13], pw1[0]=PKW(P0,8), pw1[1]=PKW(P0,10), pw1); \
    VRD(5); SBAR(); GAPA(C1=__builtin_amdgcn_mfma_f32_32x32x16_bf16(kf[3],qr[1],C1,0,0,0),   P0[14],P0[15],P1[0],P1[1],   pw1[2]=PKW(P0,12),pw1[3]=PKW(P0,14), pw1); \
    VRD(2); SBAR(); GAPA(C0=__builtin_amdgcn_mfma_f32_32x32x16_bf16(kf[4],qr[2],C0,0,0,0),   P1[2],P1[3],P1[4],P1[5],     pw2[0]=PKW(P1,0), pw2[1]=PKW(P1,2), pw2); \
    VRD(6); SBAR(); GAPA(C1=__builtin_amdgcn_mfma_f32_32x32x16_bf16(kf[5],qr[2],C1,0,0,0),   P1[6],P1[7],P1[8],P1[9],     pw2[2]=PKW(P1,4), pw2[3]=PKW(P1,6), pw2); \
    VRD(3); SBAR(); GAPA(C0=__builtin_amdgcn_mfma_f32_32x32x16_bf16(kf[6],qr[3],C0,0,0,0),   P1[10],P1[11],P1[12],P1[13], pw3[0]=PKW(P1,8), pw3[1]=PKW(P1,10), pw3); \
    VRD(7); SBAR(); GAPA(C1=__builtin_amdgcn_mfma_f32_32x32x16_bf16(kf[7],qr[3],C1,0,0,0),   P1[14],P1[15],0.f,0.f,       pw3[2]=PKW(P1,12),pw3[3]=PKW(P1,14), pw3); \
    l_reg+=sacc; \
    if(GK){DMA_K((t)+3,sl_cur);} if(GV){DMA_V((t)+1,sl_next);} \
    CMASK(C0,C1,t); \
    { float a=MX3(C0[0],C0[1],C1[0]),b=MX3(C0[2],C0[3],C1[1]); a=MX3(a,C1[2],C1[3]); \
      _Pragma("unroll") for(int r=4;r<16;r+=4){a=MX3(a,C0[r],C0[r+1]);b=MX3(b,C0[r+2],C0[r+3]);a=MX3(a,C1[r],C1[r+1]);b=MX3(b,C1[r+2],C1[r+3]);} \
      float rm=__builtin_fmaxf(a,b); { auto rr=__builtin_amdgcn_permlane32_swap(__float_as_uint(rm),__float_as_uint(rm),false,false); rm=__builtin_fmaxf(__uint_as_float(rr[0]),__uint_as_float(rr[1])); } \
      resc=false; \
      if(__builtin_expect(__any(rm>(float)THRL),0)){ const float dl=__builtin_fmaxf(rm,0.f); mhat+=dl; \
        _Pragma("unroll") for(int r=0;r<16;++r){C0[r]-=dl;C1[r]-=dl;} \
        const float f=__builtin_amdgcn_exp2f(-dl); l_reg*=f; if(hi==0)wsf[r32]=f; resc=true; } } \
    SBAR(); \
    GAPB(o[0]=__builtin_amdgcn_mfma_f32_32x32x16_bf16(PAF(0),VFR(0),o[0],0,0,0), C0,0);  WRD(0); \
    GAPB(o[1]=__builtin_amdgcn_mfma_f32_32x32x16_bf16(PAF(0),VFR(4),o[1],0,0,0), C0,2);  WRD(4); \
    GAPB(o[0]=__builtin_amdgcn_mfma_f32_32x32x16_bf16(PAF(1),VFR(1),o[0],0,0,0), C0,4);  WRD(1); \
    GAPB(o[1]=__builtin_amdgcn_mfma_f32_32x32x16_bf16(PAF(1),VFR(5),o[1],0,0,0), C0,6);  WRD(5); \
    GAPB(o[0]=__builtin_amdgcn_mfma_f32_32x32x16_bf16(PAF(2),VFR(2),o[0],0,0,0), C0,8);  WRD(2); \
    GAPB(o[1]=__builtin_amdgcn_mfma_f32_32x32x16_bf16(PAF(2),VFR(6),o[1],0,0,0), C0,10); WRD(6); \
    GAPB(o[0]=__builtin_amdgcn_mfma_f32_32x32x16_bf16(PAF(3),VFR(3),o[0],0,0,0), C0,12); WRD(3); \
    GAPB(o[1]=__builtin_amdgcn_mfma_f32_32x32x16_bf16(PAF(3),VFR(7),o[1],0,0,0), C0,14); WRD(7); \
    GAPB(o[2]=__builtin_amdgcn_mfma_f32_32x32x16_bf16(PAF(0),WFR(0),o[2],0,0,0), C1,0); \
    GAPB(o[3]=__builtin_amdgcn_mfma_f32_32x32x16_bf16(PAF(0),WFR(4),o[3],0,0,0), C1,2); \
    KRD(GL,0); GAPB(o[2]=__builtin_amdgcn_mfma_f32_32x32x16_bf16(PAF(1),WFR(1),o[2],0,0,0), C1,4); \
    KRD(GL,1); GAPB(o[3]=__builtin_amdgcn_mfma_f32_32x32x16_bf16(PAF(1),WFR(5),o[3],0,0,0), C1,6); \
    KRD(GL,2); GAPB(o[2]=__builtin_amdgcn_mfma_f32_32x32x16_bf16(PAF(2),WFR(2),o[2],0,0,0), C1,8); \
    KRD(GL,3); GAPB(o[3]=__builtin_amdgcn_mfma_f32_32x32x16_bf16(PAF(2),WFR(6),o[3],0,0,0), C1,10); \
    GAPB(o[2]=__builtin_amdgcn_mfma_f32_32x32x16_bf16(PAF(3),WFR(3),o[2],0,0,0), C1,12); \
    GAPB(o[3]=__builtin_amdgcn_mfma_f32_32x32x16_bf16(PAF(3),WFR(7),o[3],0,0,0), C1,14); \
    }while(0)
  int t=1;
  #undef CMASK
  #define CMASK(P0,P1,t) do{}while(0)
  for(;t+5<NT;t+=2){
    STEP(pB0,pB1,pA0,pA1,t,true,true,true);     WAIT_BAR(3); RESC(); ROT();
    STEP(pA0,pA1,pB0,pB1,t+1,true,true,true);   WAIT_BAR(3); RESC(); ROT();
  }
  #undef CMASK
  #define CMASK(P0,P1,t) do{int jb_=(t)-(NT-4); if(jb_>=0)cmask(P0,P1,jb_,qrel,hi);}while(0)
  #define ENDW(tt) do{ if((tt)+3<NT){WAIT_BAR(3);} else if((tt)+2<NT){WAIT_BAR(2);} else {WAIT_BAR(0);} }while(0)
  for(;t+1<NT;t+=2){
    STEP(pB0,pB1,pA0,pA1,t,(t+3<NT),(t+1<NT),(t+1<NT));       ENDW(t);   RESC(); ROT();
    STEP(pA0,pA1,pB0,pB1,t+1,(t+4<NT),(t+2<NT),(t+2<NT));     ENDW(t+1); RESC(); ROT();
  }
  STEP(pB0,pB1,pA0,pA1,NT-1,false,false,false); RESC();
  { float sacc=pB0[0]+pB0[1]; _Pragma("unroll") for(int r=2;r<16;++r)sacc+=pB0[r]; _Pragma("unroll") for(int r=0;r<16;++r)sacc+=pB1[r]; l_reg+=sacc;
    pw0=(u32x4){PKW(pB0,0),PKW(pB0,2),PKW(pB0,4),PKW(pB0,6)};pw1=(u32x4){PKW(pB0,8),PKW(pB0,10),PKW(pB0,12),PKW(pB0,14)};pw2=(u32x4){PKW(pB1,0),PKW(pB1,2),PKW(pB1,4),PKW(pB1,6)};pw3=(u32x4){PKW(pB1,8),PKW(pB1,10),PKW(pB1,12),PKW(pB1,14)};
    SBAR(); pv(o,vb0+2*sl_cur,PAF(0),PAF(1),PAF(2),PAF(3)); pv(o+2,vb0+2*sl_cur+SLOTB,PAF(0),PAF(1),PAF(2),PAF(3)); }
  #undef PKW
  #undef PAF
  #undef VFR
  #undef WFR
  #undef PIN
  #undef MX3
  #undef GAPA
  #undef GAPB
  #undef EX
  #undef VRD
  #undef WRD
  #undef KRD
  #undef STEP
  #undef ENDW
  asm volatile("s_waitcnt lgkmcnt(0)\n\ts_barrier":::"memory");
  if(has_next){ const bf16*nk=nKh+(long)((wid&1)*32+(lane&31))*DMQ+((wid>>1)*2+(lane>>5))*8; const bf16*nv=nVh+(long)(16*(wid&3)+(lane>>2))*DMQ+(wid>>2)*32+(lane&3)*8;
    glds16(nk,(unsigned)__builtin_amdgcn_readfirstlane(kdst)); glds16(nv,(unsigned)__builtin_amdgcn_readfirstlane(vdst)); glds16(nv+64,(unsigned)__builtin_amdgcn_readfirstlane(vdst+SLOTB));
    glds16(nk+(long)KVBLK*DMQ,(unsigned)__builtin_amdgcn_readfirstlane(kdst+SLOTB)); glds16(nk+(long)2*KVBLK*DMQ,(unsigned)__builtin_amdgcn_readfirstlane(kdst+2*SLOTB)); }
  {auto rr=__builtin_amdgcn_permlane32_swap(__float_as_uint(l_reg),__float_as_uint(l_reg),false,false);l_reg=__uint_as_float(rr[0])+__uint_as_float(rr[1]);}
  if(hi==0)wsf[32+r32]=l_reg;asm volatile("s_waitcnt lgkmcnt(0)":::"memory");
  #pragma unroll
  for(int r=0;r<16;++r){const float rl=__builtin_amdgcn_rcpf(wsf[32+crow(r,hi)]); o[0][r]*=rl; o[1][r]*=rl; o[2][r]*=rl; o[3][r]*=rl;}
  f32x4*sp=(f32x4*)scr+((size_t)wid*16)*64+lane;
  if(mode==1){
    #pragma unroll
    for(int d0=0;d0<4;++d0)
      #pragma unroll
      for(int rq=0;rq<4;++rq)sp[(d0*4+rq)*64]=(f32x4){o[d0][4*rq],o[d0][4*rq+1],o[d0][4*rq+2],o[d0][4*rq+3]};
  } else {
    bf16*Ow=Oh+(long)(q0+wid*QBLK)*DMO;
    bf16*stg=(bf16*)(shm+V2_LDS_OST)+wid*2048;
    float ss[16];
    #pragma unroll
    for(int r=0;r<16;++r)ss[r]=0.f;
    #pragma unroll
    for(int d0=0;d0<4;++d0)
      #pragma unroll
      for(int rq=0;rq<4;++rq){ const f32x4 a4=__builtin_nontemporal_load(sp+(d0*4+rq)*64);
        #pragma unroll
        for(int i=0;i<4;++i){ const int r=4*rq+i; const float x=a4[i]-lam*o[d0][r]; o[d0][r]=x; ss[r]+=x*x; } }
    #pragma unroll
    for(int r=0;r<16;++r){
      ss[r]=xsum16(rowsum16(ss[r]));
      ss[r]=1.0f/sqrtf(ss[r]*(1.0f/128.0f)+1e-6f); }
    const float g0=gsub[r32]*0.8f,g1=gsub[32+r32]*0.8f,g2=gsub[64+r32]*0.8f,g3=gsub[96+r32]*0.8f;
    #pragma unroll
    for(int r=0;r<16;++r){o[0][r]*=ss[r]*g0; o[1][r]*=ss[r]*g1; o[2][r]*=ss[r]*g2; o[3][r]*=ss[r]*g3;}
    #define OSTAGE(X0,X1,COFF) do{ \
      _Pragma("unroll") for(int r=0;r<16;++r){const int orow=crow(r,hi); stg[orow*64+r32]=__float2bfloat16(X0[r]); stg[orow*64+32+r32]=__float2bfloat16(X1[r]);} \
      asm volatile("s_waitcnt lgkmcnt(0)":::"memory"); \
      _Pragma("unroll") for(int i=0;i<4;++i){const int row=i*8+(lane>>3),ch=lane&7; const u32x4 v=*(const u32x4*)(stg+row*64+ch*8); *(u32x4*)(Ow+(long)row*DMO+(COFF)+ch*8)=v;} \
      asm volatile("s_waitcnt lgkmcnt(0)":::"memory"); }while(0)
    OSTAGE(o[0],o[1],0); OSTAGE(o[2],o[3],64);
    #undef OSTAGE
  }
  if(!has_next) asm volatile("s_waitcnt lgkmcnt(0)\n\ts_barrier":::"memory");
  #undef DMA_K
  #undef DMA_V
  #undef CMASK
  #undef RESC
  #undef ROT
}
static_assert(V2_LDS_BYTES<=131072,"value-128 attention LDS");

constexpr int ATTN_LDS_BYTES=LDS_BYTES;
#undef SBAR
#undef WAIT_BAR
}

constexpr int NWAVES = 8;
#ifndef MK_N_LAUNCHES
#define MK_N_LAUNCHES 1
#endif
constexpr int PER_PHASE = 8;
constexpr int N_LAUNCHES = MK_N_LAUNCHES;
static_assert(N_LAUNCHES == 1 || N_LAUNCHES == PER_PHASE, "MK_N_LAUNCHES is 1 or 8");

constexpr int BATCH = 16, SEQ = 2048, D = 1024, FF = 2816, NGU = 2 * FF, NIN = 3072, NIN_SRC = 3080;
constexpr int M = BATCH * SEQ;
constexpr int MH = M / 2;
constexpr float RMS_EPS = 1e-6f;

constexpr size_t MiB = 1u << 20;
constexpr size_t WS_CTL = 0, CTL_ZERO_BYTES = 320 * 1024;
constexpr size_t WS_WGU1 = 2 * MiB, WS_WD1 = 14 * MiB, WS_WIN = 20 * MiB, WS_WOUT = 26 * MiB, WS_WGU2 = 28 * MiB, WS_WD2 = 40 * MiB;
constexpr size_t WS_ROPE = 46 * MiB;
constexpr size_t WS_X = 48 * MiB, X_BYTES = 2 * MiB;
constexpr size_t WS_LOGF = 56 * MiB;
constexpr size_t WS_RMS0 = 58 * MiB, WS_RMS1 = 59 * MiB, WS_RMS2 = 60 * MiB;
constexpr size_t WS_XN = 64 * MiB;
constexpr size_t WS_MIX = 128 * MiB;
constexpr size_t WS_H = 192 * MiB;
constexpr size_t WS_QKV = 192 * MiB;
constexpr size_t H_PAD = (size_t)4096 * (NIN - FF) * 2;
static_assert(H_PAD == 2 * MiB, "h chunk pad");
constexpr size_t WS_SCR = 384 * MiB, SCR_PER_CU = 3 * 8 * 2 * 16 * 64 * 4;
constexpr size_t WS_END = 432 * MiB;
static_assert(WS_WGU1 + (size_t)NGU * D * 2 <= WS_WD1 && WS_WD1 + (size_t)D * FF * 2 <= WS_WIN && WS_WIN + (size_t)NIN * D * 2 <= WS_WOUT && WS_WOUT + (size_t)D * D * 2 <= WS_WGU2 &&
              WS_WGU2 + (size_t)NGU * D * 2 <= WS_WD2 && WS_WD2 + (size_t)D * FF * 2 <= WS_ROPE && WS_ROPE + (size_t)SEQ * 16 * 4 <= WS_X && WS_X + 3 * X_BYTES <= WS_LOGF &&
              WS_LOGF + (size_t)M * 8 * 4 <= WS_XN && WS_XN + (size_t)M * D * 2 <= WS_MIX && WS_MIX + (size_t)M * D * 2 <= WS_H && WS_H + (size_t)M * FF * 2 + 8 * H_PAD <= WS_SCR &&
              WS_QKV + (size_t)M * NIN * 2 <= WS_SCR && WS_SCR + 256 * SCR_PER_CU <= WS_END, "d_ws map");
constexpr int CW_TMO = 0, CW_CODE = 1;
constexpr int CW_XMIS = 64;
constexpr int CW_BAR = 4096;
constexpr int CW_SEAM = 16384, SEAM_BANK = 128 * 64;
constexpr int CW_STAT = 65536;
enum SeamBank { SB_A = 0, SB_B = 1, SB_C = 2, SB_N = 3 };
static_assert((CW_SEAM + SB_N * SEAM_BANK) * 4 <= (int)CTL_ZERO_BYTES, "CTL words inside the memset region");

constexpr int RING_OFF = 0, RING_BYTES = 131072;
constexpr int LDSCTL_OFF = RING_BYTES, MISC_OFF = LDSCTL_OFF + 320;
constexpr int EPI_OFF = LDSCTL_OFF + 1024, EPI_BYTES = 16384 + 4096 + 64 + 4096;
constexpr int LDS_BYTES = 157696;
static_assert(MISC_OFF + 128 <= EPI_OFF && EPI_OFF + EPI_BYTES <= LDS_BYTES, "LDS map");

#define GAS __attribute__((address_space(1)))
#define LAS __attribute__((address_space(3)))
typedef unsigned short bf16;
typedef unsigned v4u __attribute__((ext_vector_type(4)));
typedef float f32x4 __attribute__((ext_vector_type(4)));
typedef short bf16x8 __attribute__((ext_vector_type(8)));
typedef GAS unsigned gu32;
typedef GAS unsigned long long gu64;
#define RLX_AGENT __ATOMIC_RELAXED, __HIP_MEMORY_SCOPE_AGENT
#define LDS_WAIT() asm volatile("s_waitcnt lgkmcnt(0)" ::: "memory")
#define VM_WAIT() asm volatile("s_waitcnt vmcnt(0)" ::: "memory")
__device__ __forceinline__ unsigned long long rt() { return __builtin_amdgcn_s_memrealtime(); }
__device__ __forceinline__ unsigned f2bf(float f) { unsigned u = __builtin_bit_cast(unsigned, f); return (u + 0x7fffu + ((u >> 16) & 1u)) >> 16; }
__device__ __forceinline__ unsigned pk2(float lo, float hi) { return f2bf(lo) | (f2bf(hi) << 16); }

#define XB_TMO      128
#define XB_XCNT(j)  (256  + 64 * (j))
#define XB_XSUB(j)  (1280 + 64 * (j))
#define XB_XGEN(j)  (2304 + 64 * (j))
#define XB_TOP      3328
#define XB_TOPGEN   3392
#define XCD_BAR_WORDS 3456
#define XB_SPIN_CAP (1u << 18)

__device__ __forceinline__ unsigned xb_ld(unsigned* p)              { return __hip_atomic_load(p, __ATOMIC_RELAXED, __HIP_MEMORY_SCOPE_AGENT); }
__device__ __forceinline__ unsigned xb_add(unsigned* p, unsigned v) { return __hip_atomic_fetch_add(p, v, __ATOMIC_RELAXED, __HIP_MEMORY_SCOPE_AGENT); }
__device__ __forceinline__ unsigned xb_xcc_id() { return (unsigned)__builtin_amdgcn_s_getreg((3 << 11) | 20) & 0xFu; }
#define XB_SPIN(cond, bar) do { unsigned _sp = 0; while (cond) { __builtin_amdgcn_s_sleep(1); \
    if ((++_sp & 255u) == 0u) { if (xb_ld(&(bar)[XB_TMO])) break; if (_sp > XB_SPIN_CAP) { atomicAdd(&(bar)[XB_TMO], 1u); break; } } } } while (0)

struct XcdBarrier {
    unsigned* bar; unsigned x; int wave;
    volatile LAS unsigned* st;
};

__device__ __forceinline__ XcdBarrier xcd_barrier_post(unsigned* bar, volatile LAS unsigned* st, int wave) {
    XcdBarrier b; b.bar = bar; b.x = xb_xcc_id(); b.st = st; b.wave = wave;
    if (wave == 0 && lane_id() == 0) (void)xb_add(&bar[XB_XCNT(b.x)], 1u);
    return b;
}
__device__ __forceinline__ void xcd_barrier_complete(unsigned* bar, unsigned x, unsigned& nloc, unsigned& nx) {
    const unsigned G = gridDim.x * gridDim.y * gridDim.z;
    unsigned sum, cnt, mine, sp = 0u;
    for (;;) {
        sum = 0u; cnt = 0u; mine = 0u;
#pragma unroll
        for (unsigned j = 0; j < 16; ++j) { const unsigned c = xb_ld(&bar[XB_XCNT(j)]); sum += c; cnt += (c > 0u) ? 1u : 0u; mine = (j == x) ? c : mine; }
        if (sum == G) break;
        __builtin_amdgcn_s_sleep(1);
        if ((++sp & 255u) == 0u) { if (xb_ld(&bar[XB_TMO])) break; if (sp > XB_SPIN_CAP) { atomicAdd(&bar[XB_TMO], 1u); break; } }
    }
    nloc = mine > 0u ? mine : 1u; nx = cnt > 0u ? cnt : 1u;
}

__device__ __forceinline__ void xcd_barrier(const XcdBarrier& b, const bool loc = false) {
    asm volatile("s_waitcnt vmcnt(0)" ::: "memory");
    __syncthreads();
    if (b.wave == 0 && lane_id() == 0) {
        unsigned* bar = b.bar;
        __builtin_amdgcn_s_waitcnt(0);
        unsigned nloc = b.st[0], nx = b.st[1];
        if (nloc == 0u) { xcd_barrier_complete(bar, b.x, nloc, nx); b.st[0] = nloc; b.st[1] = nx; }
        const unsigned old = xb_add(&bar[XB_XSUB(b.x)], 1u);
        const unsigned gen = old / nloc;
        if (old + 1u == (gen + 1u) * nloc) {
            if (loc) { asm volatile("buffer_inv sc1" ::: "memory"); }
            else {
            __builtin_amdgcn_fence(__ATOMIC_RELEASE, "agent");
            asm volatile("s_waitcnt vmcnt(0)" ::: "memory");
            const unsigned og = xb_add(&bar[XB_TOP], 1u);
            const unsigned tg = og / nx;
            asm volatile("buffer_inv sc1" ::: "memory");
            if (og + 1u == (tg + 1u) * nx) xb_add(&bar[XB_TOPGEN], 1u);
            else XB_SPIN(xb_ld(&bar[XB_TOPGEN]) == tg, bar);
            }
            asm volatile("" ::: "memory");
            xb_add(&bar[XB_XGEN(b.x)], 1u);
            asm volatile("s_waitcnt vmcnt(0)" ::: "memory");
        } else {
            asm volatile("buffer_inv sc1" ::: "memory");
            XB_SPIN(xb_ld(&bar[XB_XGEN(b.x)]) == gen, bar);
            asm volatile("" ::: "memory");
            asm volatile("s_waitcnt vmcnt(0)" ::: "memory");
        }
    }
    __syncthreads();
}

struct Frame {
    LAS unsigned char* lds;
    volatile LAS unsigned* MISC;
    gu32* ctl;
    int wave;
    int vcu, G;
};
__device__ __forceinline__ gu32* seam_word(Frame& F, int bank, int pm) { return F.ctl + CW_SEAM + bank * SEAM_BANK + 64 * pm; }

__device__ __forceinline__ float wave_sum(float v) {
    const int lane = lane_id();
#pragma unroll
    for (int o = 1; o < 64; o <<= 1) v += shfl_xor_l(v, o, lane);
    return v;
}
__device__ __forceinline__ int w_drow(int mode, int n) {
    if (mode == 1) return 256 * (n >> 7) + (n & 127);
    if (mode == 2) return 256 * (n >> 7) + 128 + (n & 127);
    if (mode == 4) { const int c = 1536 + n; if (c < 2560) { const int d = c & 63; const int p = (d >= 4 && d < 8) ? d + 4 : ((d >= 8 && d < 12) ? d - 4 : d); return (c & ~63) + p; } return c; }
    return n;
}
__device__ __forceinline__ void p0_transpose_item(const float* W, int ldw, int K, int N, bf16* WT, int mode, LAS float* scr, int item, int lane, const float* gain  ) {
    const int nblk = N / 32, kb = item / nblk, nb = item % nblk, k0 = 64 * kb, n0 = 32 * nb;
    const float wscale = (mode == 1) ? -1.4426950408889634f : (mode == 2) ? -0.6931471805599453f : 1.f;
    f32x4 v[8];
#pragma unroll
    for (int i = 0; i < 8; ++i) { const int kk = 8 * i + (lane >> 3); v[i] = __builtin_nontemporal_load((const GAS f32x4*)(W + (size_t)(k0 + kk) * ldw + n0) + (lane & 7)); }
#pragma unroll
    for (int i = 0; i < 8; ++i) { const int kk = 8 * i + (lane >> 3); const float gk = (gain ? gain[k0 + kk] : 1.f) * wscale; LAS float* d = scr + kk * 33 + 4 * (lane & 7);
        d[0] = v[i].x * gk; d[1] = v[i].y * gk; d[2] = v[i].z * gk; d[3] = v[i].w * gk; }
    LDS_WAIT(); asm volatile("" ::: "memory");
    const int c = lane & 7;
#pragma unroll
    for (int j = 0; j < 4; ++j) { const int n = (lane >> 3) + 8 * j; const LAS float* s = scr + (8 * c) * 33 + n;
        v4u o; o.x = pk2(s[0 * 33], s[1 * 33]); o.y = pk2(s[2 * 33], s[3 * 33]); o.z = pk2(s[4 * 33], s[5 * 33]); o.w = pk2(s[6 * 33], s[7 * 33]);
        *(GAS v4u*)(WT + (size_t)w_drow(mode, n0 + n) * K + k0 + 8 * c) = o; }
    LDS_WAIT(); asm volatile("" ::: "memory");
}
template <int NR> __device__ __forceinline__ void rms_rows_to_bf16(const float* x0, bf16* o0, float* rms0, int lane) {
    f32x4 v[NR][4]; float s[NR];
#pragma unroll
    for (int r = 0; r < NR; ++r) { const GAS f32x4* xr = (const GAS f32x4*)(x0 + (size_t)r * D) + lane;
#pragma unroll
        for (int j = 0; j < 4; ++j) v[r][j] = __builtin_nontemporal_load(xr + 64 * j); }
#pragma unroll
    for (int r = 0; r < NR; ++r) { s[r] = 0.f;
#pragma unroll
        for (int j = 0; j < 4; ++j) s[r] += (v[r][j].x * v[r][j].x + v[r][j].y * v[r][j].y) + (v[r][j].z * v[r][j].z + v[r][j].w * v[r][j].w); }
#pragma unroll
    for (int r = 0; r < NR; ++r) s[r] = xsum32(xsum16(rowsum16(s[r])));
#pragma unroll
    for (int r = 0; r < NR; ++r) { const float rstd = 1.f / sqrtf(s[r] * (1.f / D) + RMS_EPS);
        if (lane == 0) rms0[r] = 1.0f / rstd;
        GAS unsigned long long* o8 = (GAS unsigned long long*)(o0 + (size_t)r * D) + lane;
#pragma unroll
        for (int j = 0; j < 4; ++j) { const f32x4 y = v[r][j] * rstd; o8[64 * j] = (unsigned long long)pk2(y.x, y.y) | ((unsigned long long)pk2(y.z, y.w) << 32); } }
}
__device__ __forceinline__ void sincos_d(double a, float& sn, float& cs) {
    const double k = __builtin_rint(a * 0.63661977236758134308), y = a - k * 1.57079632679489661923, y2 = y * y;
    double s = -1.0 / 1307674368000.0; s = s * y2 + 1.0 / 6227020800.0; s = s * y2 - 1.0 / 39916800.0; s = s * y2 + 1.0 / 362880.0; s = s * y2 - 1.0 / 5040.0; s = s * y2 + 1.0 / 120.0; s = s * y2 - 1.0 / 6.0; s = s * y2 + 1.0; s = s * y;
    double c = 1.0 / 87178291200.0; c = c * y2 - 1.0 / 479001600.0; c = c * y2 + 1.0 / 3628800.0; c = c * y2 - 1.0 / 40320.0; c = c * y2 + 1.0 / 720.0; c = c * y2 - 1.0 / 24.0; c = c * y2 + 0.5; c = 1.0 - c * y2;
    const int q = ((int)k) & 3;
    const double ss = (q == 0) ? s : (q == 1) ? c : (q == 2) ? -s : -c, cc = (q == 0) ? c : (q == 1) ? -s : (q == 2) ? -c : s;
    sn = (float)ss; cs = (float)cc;
}
struct Args { const float* in[21]; float* out; unsigned char* ws; int ph_lo, ph_hi; };
#ifndef W_ITEMS_P0
#define W_ITEMS_P0 (4 * 1408 + 2 * 1408 + 2 * 768 + 512)
#endif
__device__ __forceinline__ void p0_weights(Frame& F, const Args& a, unsigned char* ws, int it_lo, int it_hi);
__device__ __forceinline__ void p0_prologue(Frame& F, const Args& a, unsigned char* ws) {
    const int lane = lane_id();
    LAS float* scr = (LAS float*)(F.lds + RING_OFF + F.wave * 16384);
    const int gw = F.vcu * NWAVES + F.wave, NGW = F.G * NWAVES;
    { bf16* XN = (bf16*)(ws + WS_XN);
      float* R0 = (float*)(ws + WS_RMS0);
      if (F.G == 256) {
          const int xl = F.vcu >> 5, wi = (F.vcu & 31) * NWAVES + F.wave;
          for (int k = 3; k >= 0; --k) { const int m = 4096 * xl + 1024 * k + 4 * wi; rms_rows_to_bf16<4>(a.in[0] + (size_t)m * D, XN + (size_t)m * D, R0 + m, lane); } }
      else for (int m = 4 * gw; m < M; m += 4 * NGW) rms_rows_to_bf16<4>(a.in[0] + (size_t)m * D, XN + (size_t)m * D, R0 + m, lane); }
    p0_weights(F, a, ws, 0, W_ITEMS_P0);
    { GAS v4u* xs = (GAS v4u*)(ws + WS_X); const v4u ones = (v4u){~0u, ~0u, ~0u, ~0u};
      for (int i = gw * 64 + lane; i < (int)(3 * X_BYTES / 16); i += NGW * 64) xs[i] = ones; }
    { float* rope = (float*)(ws + WS_ROPE);
      for (int i = ((NWAVES - 1 - F.wave) * F.G + F.vcu) * 64 + lane; i < SEQ * 8; i += NGW * 64) { const int pos = i >> 3, j = i & 7;
          const unsigned ifb = (j == 0) ? 0x3f800000u : (j == 1) ? 0x3e4693afu : (j == 2) ? 0x3d1a08c8u : (j == 3) ? 0x3beef74eu : (j == 4) ? 0x3ab95d22u : (j == 5) ? 0x398fc8f8u : (j == 6) ? 0x385f10c5u : 0x372d07a8u;
          const float ang = (float)pos * __uint_as_float(ifb); float sn, cs; sincos_d((double)ang, sn, cs); rope[pos * 16 + j] = cs; rope[pos * 16 + 8 + j] = sn; } }
}
__device__ __forceinline__ void p0_weights(Frame& F, const Args& a, unsigned char* ws, int it_lo, int it_hi) {
    const int lane = lane_id();
    LAS float* scr = (LAS float*)(F.lds + RING_OFF + F.wave * 16384);
    const int gw = F.vcu * NWAVES + F.wave, NGW = F.G * NWAVES;
    constexpr int I_GU = (D / 64) * (FF / 32), I_DN = (FF / 64) * (D / 32), I_IN = (D / 64) * (1536 / 32), I_O = (D / 64) * (D / 32);
    constexpr int NITEMS = 4 * I_GU + 2 * I_DN + 2 * I_IN + I_O;
    const int nfull = ((it_hi - it_lo) / NGW) * NGW;
    for (int jt = gw; jt < (it_hi - it_lo) + NGW; jt += NGW) {
        int it;
        if (jt < nfull) it = it_lo + jt;
        else { if (F.wave != 0) break; it = it_lo + nfull + (jt - nfull) / NWAVES; if (it >= it_hi) break; }
        int r = it;
        if (r < I_GU) { p0_transpose_item(a.in[3], FF, D, FF, (bf16*)(ws + WS_WGU1), 1, scr, r, lane, a.in[1]); continue; } r -= I_GU;
        if (r < I_GU) { p0_transpose_item(a.in[4], FF, D, FF, (bf16*)(ws + WS_WGU1), 2, scr, r, lane, a.in[1]); continue; } r -= I_GU;
        if (r < I_DN) { p0_transpose_item(a.in[5], D, FF, D, (bf16*)(ws + WS_WD1), 0, scr, r, lane, nullptr); continue; } r -= I_DN;
        if (r < I_IN) { p0_transpose_item(a.in[8], NIN_SRC, D, 1536, (bf16*)(ws + WS_WIN), 0, scr, r, lane, a.in[6]); continue; } r -= I_IN;
        if (r < I_IN) { p0_transpose_item(a.in[8] + 1544, NIN_SRC, D, 1536, (bf16*)(ws + WS_WIN), 4, scr, r, lane, a.in[6]); continue; } r -= I_IN;
        if (r < I_O)  { p0_transpose_item(a.in[15], D, D, D, (bf16*)(ws + WS_WOUT), 0, scr, r, lane, nullptr); continue; } r -= I_O;
        if (r < I_GU) { p0_transpose_item(a.in[18], FF, D, FF, (bf16*)(ws + WS_WGU2), 1, scr, r, lane, a.in[16]); continue; } r -= I_GU;
        if (r < I_GU) { p0_transpose_item(a.in[19], FF, D, FF, (bf16*)(ws + WS_WGU2), 2, scr, r, lane, a.in[16]); continue; } r -= I_GU;
        p0_transpose_item(a.in[20], D, FF, D, (bf16*)(ws + WS_WD2), 0, scr, r, lane, nullptr);
    }
}
__device__ __forceinline__ void nan_rows_f32(Frame& F, float* out) {
    const int gw = F.vcu * NWAVES + F.wave, NGW = F.G * NWAVES; const float q = __builtin_nanf(""); const int lane = lane_id();
    for (int m = gw; m < M; m += NGW) { GAS f32x4* o = (GAS f32x4*)(out + (size_t)m * D) + lane;
#pragma unroll
        for (int j = 0; j < 4; ++j) o[64 * j] = (f32x4){q, q, q, q}; }
}
__device__ __forceinline__ void wrong_grid_word(Frame& F) {
    if (blockIdx.x == 0 && F.wave == 0 && lane_id() == 0) { unsigned expect = 0u; __hip_atomic_compare_exchange_strong((unsigned*)(F.ctl + CW_CODE), &expect, 0x7f0u, __ATOMIC_RELAXED, __ATOMIC_RELAXED, __HIP_MEMORY_SCOPE_AGENT);
        __hip_atomic_store(F.ctl + CW_TMO, 1u, RLX_AGENT); }
}

__global__ void __launch_bounds__(NWAVES * 64, 2) skel_fwd(Args args) {
    extern __shared__ __attribute__((aligned(16))) unsigned char lds[];
    Frame F;
    F.lds = (LAS unsigned char*)lds;
    F.MISC = (volatile LAS unsigned*)(F.lds + MISC_OFF);
    F.wave = __builtin_amdgcn_readfirstlane((int)threadIdx.x >> 6);
    F.G = gridDim.x; { const int bx = blockIdx.x; F.vcu = (F.G % 8 == 0) ? (bx % 8) * (F.G / 8) + bx / 8 : bx; }
#define GRID_BAR(seam) do { if (N_LAUNCHES == PER_PHASE) { if (F.wave == 0 && lane_id() == 0) __hip_atomic_store(F.ctl + CW_TMO, 0xBADBA0u | (unsigned)(seam), RLX_AGENT); } \
    else { xcd_barrier(bar); } } while (0)
#define XCD_BAR(seam) do { if (N_LAUNCHES == PER_PHASE) { if (F.wave == 0 && lane_id() == 0) __hip_atomic_store(F.ctl + CW_TMO, 0xBADBA0u | (unsigned)(seam), RLX_AGENT); } \
    else { xcd_barrier(bar, xlocal); } } while (0)
    unsigned char* ws = args.ws;
    F.ctl = (gu32*)(ws + WS_CTL);
    bf16* const XN = (bf16*)(ws + WS_XN); bf16* const HB = (bf16*)(ws + WS_H); bf16* const QKV = (bf16*)(ws + WS_QKV); bf16* const MIX = (bf16*)(ws + WS_MIX);
    float* const LOGF = (float*)(ws + WS_LOGF);
    for (int u = F.wave * 64 + lane_id(); u < (LDS_BYTES - LDSCTL_OFF) / 4; u += NWAVES * 64) ((LAS unsigned*)(F.lds + LDSCTL_OFF))[u] = 0u;
    __syncthreads();
    if (F.wave == 0) {
        const int lane = lane_id();
        const float p1 = args.in[10][lane] * args.in[11][lane], p2 = args.in[12][lane] * args.in[13][lane];
        const float s1 = wave_sum(p1), s2 = wave_sum(p2);
        if (lane == 0) ((volatile LAS float*)F.MISC)[16] = expf(s1) - expf(s2) + 0.2f;
    }
    __syncthreads();
    XcdBarrier bar; bar.bar = (unsigned*)(F.ctl + CW_BAR); bar.x = 0; bar.st = nullptr; bar.wave = F.wave;
    if (N_LAUNCHES != PER_PHASE && F.wave == 0 && lane_id() == 0 && (xb_xcc_id() != (blockIdx.x & 7u) || gridDim.x != 256u)) __hip_atomic_fetch_or(F.ctl + CW_XMIS, 1u, RLX_AGENT);
    bool xlocal = false;
    if (N_LAUNCHES != PER_PHASE) bar = xcd_barrier_post((unsigned*)(F.ctl + CW_BAR), F.MISC + 8, F.wave);

    const int lo = args.ph_lo, hi = args.ph_hi;
#define IN(k) (lo <= (k) && (k) < hi)
#define BOTH(k) (IN(k) && IN((k) + 1))

#ifndef REV_P2
#define REV_P2 8
#endif
#ifndef REV_P7
#define REV_P7 REV_P2
#endif
#ifndef REV_P6
#define REV_P6 0
#endif
#ifndef REV_P5
#define REV_P5 0
#endif
#ifndef WGM_FUSED
#define WGM_FUSED 8
#endif
#ifndef WGM_NGU
#define WGM_NGU 4
#endif
#ifndef WGM_NIN
#define WGM_NIN 2
#endif
#ifndef REP0
#define REP0 1
#endif
#ifndef REP1
#define REP1 1
#endif
#ifndef REP3
#define REP3 1
#endif
#ifndef REP4
#define REP4 1
#endif
    if (IN(0)) { for (int rep = 0; rep < REP0; ++rep) { p0_prologue(F, args, ws); LDS_WAIT(); __syncthreads(); } if (BOTH(0)) { GRID_BAR(0); xlocal = (N_LAUNCHES != PER_PHASE) && (__builtin_amdgcn_readfirstlane((int)__hip_atomic_load(F.ctl + CW_XMIS, RLX_AGENT)) == 0); } }

    if (IN(1)) {
#pragma unroll 1
        for (int rep = 1; rep < REP1; ++rep) { pg8::Gemm g{XN, (const bf16*)(ws + WS_WGU1), M, NGU, D}; pg8::StaticOrder S; S.init(M, NGU, F.G, (int)blockIdx.x, WGM_NGU); pg8::EpiSwiglu E{HB, FF, (int)(H_PAD / 2)};
            pg8::gemm_phase<pg8::EpiSwiglu, pg8::StaticOrder, PG8_ALIGN, PG8_SP2>(F.lds + RING_OFF, g, S, E, F.wave); LDS_WAIT(); __syncthreads(); }
        pg8::Gemm g{XN, (const bf16*)(ws + WS_WGU1), M, NGU, D}; pg8::StaticOrder S; S.init(M, NGU, F.G, (int)blockIdx.x, WGM_NGU);
        pg8::EpiSwiglu E{HB, FF, (int)(H_PAD / 2)};
        pg8::gemm_phase<pg8::EpiSwiglu, pg8::StaticOrder, PG8_ALIGN, PG8_SP2>(F.lds + RING_OFF, g, S, E, F.wave);
        if (BOTH(1)) XCD_BAR(1);
    }

    if (IN(2)) {
        unsigned poison = (__hip_atomic_load(F.ctl + CW_TMO, RLX_AGENT) != 0u);
        if (F.G != 256) { nan_rows_f32(F, args.out); wrong_grid_word(F); VM_WAIT(); __syncthreads(); }
        else {
        {
            pg8::Gemm g{HB, (const bf16*)(ws + WS_WD1), M, D, FF, (int)H_PAD}; pg8::StaticOrder S; S.init(M, D, F.G, (int)blockIdx.x, WGM_FUSED, REV_P2);
            pg8::EpiFused<false, 1> E{XN, (const float*)(ws + WS_RMS0), XN, (float*)(ws + WS_RMS1), nullptr, args.in[2], D,
                                      (unsigned long long*)(ws + WS_X + 0 * X_BYTES), (unsigned*)seam_word(F, SB_A, 0), (unsigned*)(F.ctl + CW_TMO), 0x740u, poison};
            E.fill_gains(F.lds + EPI_OFF, F.wave * 64 + lane_id()); LDS_WAIT(); __syncthreads();
            pg8::gemm_phase<pg8::EpiFused<false, 1>, pg8::StaticOrder, true, PG8_SP2>(F.lds + RING_OFF, g, S, E, F.wave, F.lds + EPI_OFF);
        }
        }
        if (BOTH(2)) XCD_BAR(2);
    }

    if (IN(3)) {
#pragma unroll 1
        for (int rep = 0; rep < REP3; ++rep) {
        {
            LAS unsigned short* wt = (LAS unsigned short*)(F.lds + RING_OFF);
            const float* win = args.in[8]; const int lane = lane_id();
            const int c16 = lane & 15, g4 = lane >> 4;
            const int gw = F.vcu * NWAVES + F.wave;
            static_assert(M / 16 == 256 * NWAVES, "one 16-row group per wave of the 256-workgroup grid (any other grid is refused by the fused phases)");
            const int rg = gw & (M / 16 - 1);
            const GAS v4u* xr = (const GAS v4u*)(XN + (size_t)(rg * 16 + c16) * D + 8 * g4);
            v4u xq[32];
#pragma unroll
            for (int kb = 0; kb < 32; ++kb) xq[kb] = xr[kb * 4];
            { f32x4 wv[2][2]; float gk[2];
#pragma unroll
              for (int q = 0; q < 2; ++q) { const int k = F.wave * 64 + lane + 512 * q; const GAS f32x4* src = (const GAS f32x4*)(win + (size_t)k * NIN_SRC + 1536); wv[q][0] = src[0]; wv[q][1] = src[1]; gk[q] = args.in[6][k]; }
#pragma unroll
              for (int q = 0; q < 2; ++q) { const int k = F.wave * 64 + lane + 512 * q; const int kb = k >> 5, g = (k >> 3) & 3, jj = k & 7;
#pragma unroll
                  for (int c = 0; c < 8; ++c) { const float v = wv[q][c >> 2][c & 3] * gk[q]; const unsigned hi = f2bf(v), lo = f2bf(v - __uint_as_float(hi << 16));
                      const int idx = ((kb * 64 + g * 16 + c) * 16) + jj; wt[idx] = (unsigned short)hi; wt[idx + 8] = (unsigned short)lo; } } }
            const float fb = (c16 < 8) ? args.in[9][c16] : 0.f;
            LDS_WAIT(); __syncthreads();
            {
                f32x4 acc0 = (f32x4){0.f, 0.f, 0.f, 0.f}, acc1 = (f32x4){0.f, 0.f, 0.f, 0.f};
#pragma unroll
                for (int kb = 0; kb < 32; ++kb) { const bf16x8 xa = __builtin_bit_cast(bf16x8, xq[kb]);
                    const bf16x8 bh = *(const LAS bf16x8*)(wt + (kb * 64 + lane) * 16), bl = *(const LAS bf16x8*)(wt + (kb * 64 + lane) * 16 + 8);
                    acc0 = __builtin_amdgcn_mfma_f32_16x16x32_bf16(xa, bh, acc0, 0, 0, 0); acc1 = __builtin_amdgcn_mfma_f32_16x16x32_bf16(xa, bl, acc1, 0, 0, 0); }
                const f32x4 acc = acc0 + acc1;
                if (c16 < 8) {
                    f32x4 lf4;
#pragma unroll
                    for (int r = 0; r < 4; ++r) { const float z = acc[r] + fb; lf4[r] = fminf(z, 0.f) - log1pf(expf(-fabsf(z))); }
                    const int row0 = rg * 16 + g4 * 4;
                    *(GAS f32x4*)(LOGF + ((size_t)((row0 >> 11) * 8 + c16) * SEQ + (row0 & (SEQ - 1)))) = lf4; }
            }
            LDS_WAIT(); __syncthreads();
        }
        pg8::Gemm g{XN, (const bf16*)(ws + WS_WIN), M, NIN, D}; pg8::StaticOrder S; S.init(M, NIN, F.G, (int)blockIdx.x, WGM_NIN);
        pg8::EpiQKV E{QKV, NIN, (const float*)(ws + WS_ROPE), attn_body::C2, SEQ - 1, (unsigned*)(F.ctl + CW_STAT)};
        pg8::gemm_phase<pg8::EpiQKV, pg8::StaticOrder, PG8_ALIGN, PG8_SP2>(F.lds + RING_OFF, g, S, E, F.wave);
        if (REP3 > 1) { LDS_WAIT(); __syncthreads(); }
        }
        if (BOTH(3)) XCD_BAR(3);
    }

    if (IN(4)) {
        static_assert(attn_body::ATTN_LDS_BYTES <= RING_BYTES, "attention body geometry vs frame");
        if (F.G != 256) { nan_rows_f32(F, args.out); wrong_grid_word(F); VM_WAIT(); __syncthreads(); }
        else {
        const float lam = ((volatile LAS float*)F.MISC)[16];
#pragma unroll 1
        for (int rep = 0; rep < REP4; ++rep) {
        char* shm = (char*)lds + RING_OFF;
        const int v = F.vcu;
        typedef attn_body::bf16 hb;
#ifndef REPF
#define REPF 1
#endif
#ifndef REPD
#define REPD 1
#endif
        {
            const int bh = v >> 2, b = bh >> 2, h = bh & 3, s = v & 3;
            const hb* base = (const hb*)QKV + (size_t)b * SEQ * NIN; float* scr = (float*)(ws + WS_SCR + (size_t)blockIdx.x * SCR_PER_CU);
#pragma unroll 1
            for (int u = 0; u < 4 * REPD; ++u) { const int qb = ((u >> 1) & 1) ? 7 - s : s, mp = u & 1;
                const int nmp = (u + 1) & 1;
                attn_body::attn_unit128<8>(qb, base + 1536 + h * 128 + mp * 64, base + 2048 + h * 128 + mp * 64, base + 2560 + h * 128, (hb*)MIX + (size_t)b * SEQ * D + 512 + h * 128,
                                           mp == 0 ? 1 : 2, scr, lam, args.in[14], shm, F.wave, u > 0, u + 1 < 4 * REPD, base + 2048 + h * 128 + nmp * 64, base + 2560 + h * 128); }
        }
#pragma unroll 1
        for (int rp = 0; rp < REPF; ++rp) {
            const int bh = v >> 1, s0 = 2 * (v & 1), b = bh >> 3, h = bh & 7;
            const hb* base = (const hb*)QKV + (size_t)b * SEQ * NIN;
            const float qh = __uint_as_float(__hip_atomic_load(F.ctl + CW_STAT + (b * 8 + h) * 2, RLX_AGENT)), kh = __uint_as_float(__hip_atomic_load(F.ctl + CW_STAT + (b * 8 + h) * 2 + 1, RLX_AGENT));
            const float thr = 60.f + 4.f * 1.03f * sqrtf(qh * kh);
            int sk0, sk1, sk2, sk3;
            attn_body::fox_bias_table(LOGF + (size_t)(b * 8 + h) * SEQ, s0 * 256, (7 - s0) * 256, (s0 + 1) * 256, (6 - s0) * 256, shm, F.wave, thr, sk0, sk1, sk2, sk3);
#pragma unroll 1
            for (int j = 0; j < 4; ++j) {
                const int qb = (j == 0) ? s0 : (j == 1) ? 7 - s0 : (j == 2) ? s0 + 1 : 6 - s0, sk = (j == 0) ? sk0 : (j == 1) ? sk1 : (j == 2) ? sk2 : sk3;
                const int nsk = (j == 0) ? sk1 : (j == 1) ? sk2 : sk3;
                attn_body::attn_unit<8, true>(qb, sk, base + h * 64, base + 512 + h * 64, base + 1024 + h * 64, (hb*)MIX + (size_t)b * SEQ * D + h * 64, 0, nullptr, 0, 0.f, nullptr, shm, F.wave,
                                              j > 0, j < 3, base + 512 + h * 64 + (size_t)nsk * 64 * NIN, base + 1024 + h * 64 + (size_t)nsk * 64 * NIN); }
        }
        }
        }
        if (BOTH(4)) XCD_BAR(4);
    }

    if (IN(5)) {
        unsigned poison = (__hip_atomic_load(F.ctl + CW_TMO, RLX_AGENT) != 0u);
        if (F.G != 256) { nan_rows_f32(F, args.out); wrong_grid_word(F); VM_WAIT(); __syncthreads(); }
        else {
        {
            pg8::Gemm g{MIX, (const bf16*)(ws + WS_WOUT), M, D, D}; pg8::StaticOrder S; S.init(M, D, F.G, (int)blockIdx.x, WGM_FUSED, REV_P5);
            pg8::EpiFused<false, 2> E{XN, (const float*)(ws + WS_RMS1), XN, (float*)(ws + WS_RMS2), nullptr, args.in[7], D,
                                      (unsigned long long*)(ws + WS_X + 1 * X_BYTES), (unsigned*)seam_word(F, SB_B, 0), (unsigned*)(F.ctl + CW_TMO), 0x840u, poison};
            E.fill_gains(F.lds + EPI_OFF, F.wave * 64 + lane_id()); LDS_WAIT(); __syncthreads();
            pg8::gemm_phase<pg8::EpiFused<false, 2>, pg8::StaticOrder, true, PG8_SP2>(F.lds + RING_OFF, g, S, E, F.wave, F.lds + EPI_OFF);
        }
        }
        if (BOTH(5)) XCD_BAR(5);
    }

    if (IN(6)) {
        pg8::Gemm g{XN, (const bf16*)(ws + WS_WGU2), M, NGU, D}; pg8::StaticOrder S; S.init(M, NGU, F.G, (int)blockIdx.x, WGM_NGU, REV_P6);
        pg8::EpiSwiglu E{HB, FF, (int)(H_PAD / 2)};
        pg8::gemm_phase<pg8::EpiSwiglu, pg8::StaticOrder, PG8_ALIGN, PG8_SP2>(F.lds + RING_OFF, g, S, E, F.wave);
        if (BOTH(6)) XCD_BAR(6);
    }

    if (IN(7)) {
        unsigned poison = (__hip_atomic_load(F.ctl + CW_TMO, RLX_AGENT) != 0u);
        if (N_LAUNCHES != PER_PHASE) poison |= __hip_atomic_load((gu32*)((const unsigned*)(F.ctl + CW_BAR) + XB_TMO), RLX_AGENT) != 0u;
        if (F.G != 256) { nan_rows_f32(F, args.out); wrong_grid_word(F); }
        else {
        {
            pg8::Gemm g{HB, (const bf16*)(ws + WS_WD2), M, D, FF, (int)H_PAD}; pg8::StaticOrder S; S.init(M, D, F.G, (int)blockIdx.x, WGM_FUSED, REV_P7);
            pg8::EpiFused<true, 1> E{XN, (const float*)(ws + WS_RMS2), nullptr, nullptr, args.out, args.in[17], D,
                                     (unsigned long long*)(ws + WS_X + 2 * X_BYTES), (unsigned*)seam_word(F, SB_C, 0), (unsigned*)(F.ctl + CW_TMO), 0x700u, poison};
            E.fill_gains(F.lds + EPI_OFF, F.wave * 64 + lane_id()); LDS_WAIT(); __syncthreads();
            pg8::gemm_phase<pg8::EpiFused<true, 1>, pg8::StaticOrder, true, PG8_SP2>(F.lds + RING_OFF, g, S, E, F.wave, F.lds + EPI_OFF);
        }
        }
    }
#undef IN
#undef BOTH
}

extern "C" void kernel_launch(void* const* d_in, const int* in_sizes, int n_in, void* d_out, int out_size, void* d_ws, size_t ws_size, hipStream_t stream) {
    static int grid = 0;
    if (grid == 0) {
        if (n_in != 21 || in_sizes[0] != M * D || out_size != M * D || ws_size < WS_END) { fprintf(stderr, "kernel_launch: built for 21 inputs, x and out of %d floats, >= %zu bytes of workspace; got n_in %d, in0 %d, out %d, ws %zu; nothing launched\n", M * D, (size_t)WS_END, n_in, n_in > 0 ? in_sizes[0] : -1, out_size, ws_size); grid = -1; return; }
        int dev = 0, cus = 0, per_cu = 0;
        if (hipGetDevice(&dev) != hipSuccess || hipDeviceGetAttribute(&cus, hipDeviceAttributeMultiprocessorCount, dev) != hipSuccess) { fprintf(stderr, "kernel_launch: hipGetDevice / hipDeviceGetAttribute failed; nothing launched\n"); grid = -1; return; }
        if (hipFuncSetAttribute((const void*)skel_fwd, hipFuncAttributeMaxDynamicSharedMemorySize, LDS_BYTES) != hipSuccess) { fprintf(stderr, "kernel_launch: hipFuncSetAttribute failed: this kernel needs %d bytes of dynamic LDS per workgroup; nothing launched\n", LDS_BYTES); grid = -1; return; }
        if (hipOccupancyMaxActiveBlocksPerMultiprocessor(&per_cu, (const void*)skel_fwd, NWAVES * 64, LDS_BYTES) != hipSuccess || per_cu < 1)
            fprintf(stderr, "kernel_launch: note: the occupancy query reports %d workgroups per CU; the launch goes ahead with one per CU (%d bytes of LDS each)\n", per_cu, LDS_BYTES);
        (void)hipGetLastError();
        grid = cus;
        if (grid != 256) fprintf(stderr, "kernel_launch: launching %d workgroups; the fused phases need exactly 256, so every output will be NaN by design\n", grid);
    }
    if (grid < 0) return;
    if (hipMemsetAsync((char*)d_ws + WS_CTL, 0, CTL_ZERO_BYTES, stream) != hipSuccess) { fprintf(stderr, "kernel_launch: hipMemsetAsync of the control words failed; nothing launched\n"); return; }
    Args a{};
    for (int i = 0; i < 21; ++i) a.in[i] = (const float*)d_in[i];
    a.out = (float*)d_out; a.ws = (unsigned char*)d_ws;
    for (int li = 0; li < N_LAUNCHES; ++li) {
        a.ph_lo = (N_LAUNCHES == PER_PHASE) ? li : 0; a.ph_hi = (N_LAUNCHES == PER_PHASE) ? li + 1 : PER_PHASE;
        hipLaunchKernelGGL(skel_fwd, dim3(grid), dim3(NWAVES * 64), LDS_BYTES, stream, a);
        const hipError_t le = hipPeekAtLastError();
        if (le != hipSuccess) { fprintf(stderr, "kernel_launch: launch %d failed: %s (grid %d x %d threads, %d B LDS)\n", li, hipGetErrorName(le), grid, NWAVES * 64, LDS_BYTES); break; }
    }
}
```

```cpp
#include <hip/hip_runtime.h>
#include <cstdio>
#include <cstdint>
__device__ __forceinline__ int lane_id() { int l; asm volatile("v_mbcnt_lo_u32_b32 %0, -1, 0\n\tv_mbcnt_hi_u32_b32 %0, -1, %0" : "=v"(l)); return l; }
__device__ __forceinline__ float shfl_xor_l(float x, int mask, int lane) { return __builtin_bit_cast(float, __builtin_amdgcn_ds_bpermute((lane ^ mask) << 2, __builtin_bit_cast(int, x))); }
__device__ __forceinline__ float xsum16(float v) { const auto r = __builtin_amdgcn_permlane16_swap(__float_as_uint(v), __float_as_uint(v), false, false); return __uint_as_float(r[0]) + __uint_as_float(r[1]); }
__device__ __forceinline__ float rowsum16(float v) {
    v += __builtin_bit_cast(float, __builtin_amdgcn_update_dpp(0, __builtin_bit_cast(int, v), 0xB1, 0xF, 0xF, true));
    v += __builtin_bit_cast(float, __builtin_amdgcn_update_dpp(0, __builtin_bit_cast(int, v), 0x4E, 0xF, 0xF, true));
    v += __builtin_bit_cast(float, __builtin_amdgcn_update_dpp(0, __builtin_bit_cast(int, v), 0x124, 0xF, 0xF, true));
    v += __builtin_bit_cast(float, __builtin_amdgcn_update_dpp(0, __builtin_bit_cast(int, v), 0x128, 0xF, 0xF, true));
    return v; }
__device__ __forceinline__ float rowmax16(float v) {
    v = __builtin_fmaxf(v, __builtin_bit_cast(float, __builtin_amdgcn_update_dpp(0, __builtin_bit_cast(int, v), 0xB1, 0xF, 0xF, true)));
    v = __builtin_fmaxf(v, __builtin_bit_cast(float, __builtin_amdgcn_update_dpp(0, __builtin_bit_cast(int, v), 0x4E, 0xF, 0xF, true)));
    v = __builtin_fmaxf(v, __builtin_bit_cast(float, __builtin_amdgcn_update_dpp(0, __builtin_bit_cast(int, v), 0x124, 0xF, 0xF, true)));
    v = __builtin_fmaxf(v, __builtin_bit_cast(float, __builtin_amdgcn_update_dpp(0, __builtin_bit_cast(int, v), 0x128, 0xF, 0xF, true)));
    return v; }
__device__ __forceinline__ float xsum32(float v) { const auto r = __builtin_amdgcn_permlane32_swap(__float_as_uint(v), __float_as_uint(v), false, false); return __uint_as_float(r[0]) + __uint_as_float(r[1]); }
__device__ __forceinline__ float shfl_idx_l(float x, int src) { return __builtin_bit_cast(float, __builtin_amdgcn_ds_bpermute(src << 2, __builtin_bit_cast(int, x))); }
__device__ __forceinline__ int opaque_s(int v) { asm volatile("" : "+s"(v)); return v; }
namespace pg8 {
#define PG8_LAS __attribute__((address_space(3)))
typedef unsigned short bf16_t;
typedef short bf16x8 __attribute__((ext_vector_type(8)));
typedef float f32x4 __attribute__((ext_vector_type(4)));
typedef unsigned u32x4 __attribute__((ext_vector_type(4)));
constexpr int BM = 256, BK = 64, HALF = 128, HTB = HALF * BK * 2  , STAGE_BYTES = 8 * HTB, NXCD = 8;
#ifndef PG8_WGM
#define PG8_WGM 8
#endif
constexpr int WGM = PG8_WGM;

__host__ __device__ __forceinline__ int lds_byte(int r, int c) { const int st = (r >> 4) * 2 + (c >> 5), rr = r & 15, cc = c & 31, ob = rr * 64 + cc * 2; return st * 1024 + (ob ^ (((ob >> 9) & 1) << 5)); }
__host__ __device__ __forceinline__ void stage_rc(int b, int& R, int& C) { const int st = b / 1024, sb = b % 1024, swz = sb ^ (((sb >> 9) & 1) << 5); R = (st >> 1) * 16 + swz / 64; C = (st & 1) * 32 + (swz % 64) / 2; }
__host__ __device__ __forceinline__ int perm32(int rho) { const int n = rho >> 4, i = rho & 15; return 8 * (i >> 2) + 4 * n + (i & 3); }

struct Unit { int pm, pn; };
struct Gemm { const bf16_t* A; const bf16_t* Bt; int M, N, K; int apad = 0; };

struct StaticOrder {
    int nM, nN, nwg, G, c, wgm, rev;
    __host__ __device__ void init(int M, int N, int G_, int c_, int wgm_ = WGM, int rev_ = 0) { nM = M / BM; nN = N / BM; nwg = nM * nN; G = G_; c = c_; wgm = wgm_; rev = rev_; }
    __host__ __device__ bool next(int i, Unit& u) const {
        const long L = (long)i * G + c; if (L >= nwg) return false;
        int wgid = (int)L; { const int q = nwg / NXCD, r = nwg % NXCD, xcd = wgid % NXCD, off = wgid / NXCD; wgid = (xcd < r ? xcd * (q + 1) : r * (q + 1) + (xcd - r) * q) + off; }
        const int nig = wgm * nN, gid = wgid / nig, fm = gid * wgm, gsz = (nM - fm) < wgm ? (nM - fm) : wgm;
        u.pm = (fm + ((wgid % nig) % gsz)) ^ rev; u.pn = (wgid % nig) / gsz; return true;
    }
    __device__ __forceinline__ void a_ready(const Unit&) const {}
    __device__ __forceinline__ void done(const Unit&) const {}
};


__device__ __forceinline__ unsigned cvt_pk_bf16(float lo, float hi) { unsigned r; asm volatile("v_cvt_pk_bf16_f32 %0, %1, %2" : "=v"(r) : "v"(lo), "v"(hi)); return r; }
typedef float f32x2 __attribute__((ext_vector_type(2)));
__device__ __forceinline__ f32x2 swiglu_pk(f32x2 g, f32x2 u) {
    f32x2 e; e.x = __builtin_amdgcn_exp2f(g.x); e.y = __builtin_amdgcn_exp2f(g.y);
    const f32x2 d = e + 1.0f; f32x2 r; r.x = __builtin_amdgcn_rcpf(d.x); r.y = __builtin_amdgcn_rcpf(d.y);
    return (g * u) * r;
}

struct EpiSwiglu {
    static constexpr bool PERM = true, AFTER_DRAIN = false, INLOOP_LDS = false;
    bf16_t* O; int ldc; int opad;
    __device__ __forceinline__ void operator()(const f32x4 (&acc)[2][2][4][2], const Unit& u, int wr, int wc, int fr, int fq) const {
        const int row0 = u.pm * BM + wr * 64 + fr; const int col0 = u.pn * HALF + wc * 32 + 8 * fq;
        bf16_t* Oc = O + (size_t)(u.pm >> 4) * (size_t)opad;
#pragma unroll
        for (int ai = 0; ai < 2; ++ai)
#pragma unroll
            for (int m = 0; m < 4; ++m) { bf16_t* rowp = Oc + (size_t)(row0 + ai * HALF + m * 16) * ldc + col0;
                const f32x4 g0 = acc[ai][0][m][0], g1 = acc[ai][0][m][1], u0 = acc[ai][1][m][0], u1 = acc[ai][1][m][1];
                const f32x2 a = swiglu_pk((f32x2){g0[0], g0[1]}, (f32x2){u0[0], u0[1]}), b = swiglu_pk((f32x2){g0[2], g0[3]}, (f32x2){u0[2], u0[3]});
                const f32x2 c = swiglu_pk((f32x2){g1[0], g1[1]}, (f32x2){u1[0], u1[1]}), d = swiglu_pk((f32x2){g1[2], g1[3]}, (f32x2){u1[2], u1[3]});
                u32x4 w; w.x = cvt_pk_bf16(a.x, a.y); w.y = cvt_pk_bf16(b.x, b.y); w.z = cvt_pk_bf16(c.x, c.y); w.w = cvt_pk_bf16(d.x, d.y);
                *(u32x4*)rowp = w; }
    }
};

struct EpiQKV {
    static constexpr bool PERM = true, AFTER_DRAIN = false, INLOOP_LDS = false;
    bf16_t* O; int ldc; const float* rope; float c2; int seq_mask; unsigned* stat;
    __device__ __forceinline__ void operator()(const f32x4 (&acc)[2][2][4][2], const Unit& u, int wr, int wc, int fr, int fq) const {
        const int row0 = u.pm * BM + wr * 64 + fr; const int region = u.pn >> 1;
        const float sc = (region == 0 || region == 3) ? c2 : 1.f;
        const bool roper = (region == 3 || region == 4) && ((wc & 1) == 0) && (fq < 2);
        const int col0 = u.pn * BM + wc * 32 + 8 * fq;
        if (region <= 1) {
            const int lane = fq * 16 + fr;
#pragma unroll
            for (int bj = 0; bj < 2; ++bj) { float mx = 0.f;
#pragma unroll
                for (int ai = 0; ai < 2; ++ai)
#pragma unroll
                    for (int m = 0; m < 4; ++m) { const f32x4 a = acc[ai][bj][m][0] * sc, b = acc[ai][bj][m][1] * sc;
                        float s = ((a[0] * a[0] + a[1] * a[1]) + (a[2] * a[2] + a[3] * a[3])) + ((b[0] * b[0] + b[1] * b[1]) + (b[2] * b[2] + b[3] * b[3]));
                        s = xsum32(xsum16(s)); mx = __builtin_fmaxf(mx, s); }
                mx = rowmax16(mx);
                if (lane == 0) __hip_atomic_fetch_max(stat + (((u.pm >> 3) * 8 + (u.pn & 1) * 4 + bj * 2 + (wc >> 1)) * 2 + region), __float_as_uint(mx), __ATOMIC_RELAXED, __HIP_MEMORY_SCOPE_AGENT); }
        }
        if (region == 3 || region == 4) {
            f32x4 csv[2][4], snv[2][4];
#pragma unroll
            for (int ai = 0; ai < 2; ++ai)
#pragma unroll
                for (int m = 0; m < 4; ++m) { const int row = row0 + ai * HALF + m * 16; const float* rp = rope + (size_t)(row & seq_mask) * 16 + 4 * (fq & 1); csv[ai][m] = *(const f32x4*)rp; snv[ai][m] = *(const f32x4*)(rp + 8); }
#pragma unroll
            for (int ai = 0; ai < 2; ++ai)
#pragma unroll
                for (int m = 0; m < 4; ++m) { const int row = row0 + ai * HALF + m * 16; bf16_t* rowp = O + (size_t)row * ldc + col0;
                    const f32x4 cs = roper ? csv[ai][m] : (f32x4){1.f, 1.f, 1.f, 1.f}, sn = roper ? snv[ai][m] : (f32x4){0.f, 0.f, 0.f, 0.f};
#pragma unroll
                    for (int bj = 0; bj < 2; ++bj) { const f32x4 x0 = acc[ai][bj][m][0], x1 = acc[ai][bj][m][1];
                        const f32x4 v0 = (x0 * cs - x1 * sn) * sc, v1 = (x1 * cs + x0 * sn) * sc;
                        u32x4 w; w.x = cvt_pk_bf16(v0[0], v0[1]); w.y = cvt_pk_bf16(v0[2], v0[3]); w.z = cvt_pk_bf16(v1[0], v1[1]); w.w = cvt_pk_bf16(v1[2], v1[3]);
                        *(u32x4*)(rowp + bj * HALF) = w; } }
        } else {
#pragma unroll
        for (int ai = 0; ai < 2; ++ai)
#pragma unroll
            for (int m = 0; m < 4; ++m) { const int row = row0 + ai * HALF + m * 16; bf16_t* rowp = O + (size_t)row * ldc + col0;
#pragma unroll
                for (int bj = 0; bj < 2; ++bj) { const f32x4 v0 = acc[ai][bj][m][0] * sc, v1 = acc[ai][bj][m][1] * sc;
                    u32x4 w; w.x = cvt_pk_bf16(v0[0], v0[1]); w.y = cvt_pk_bf16(v0[2], v0[3]); w.z = cvt_pk_bf16(v1[0], v1[1]); w.w = cvt_pk_bf16(v1[2], v1[3]);
                    *(u32x4*)(rowp + bj * HALF) = w; } }
        }
    }
};

#define PG8_GAS __attribute__((address_space(1)))
__device__ __forceinline__ f32x4 bf16x4_to_f32(unsigned lo, unsigned hi) { return (f32x4){__uint_as_float(lo << 16), __uint_as_float(lo & 0xffff0000u), __uint_as_float(hi << 16), __uint_as_float(hi & 0xffff0000u)}; }
__device__ __forceinline__ float dot4(f32x4 a, f32x4 b) { return (a[0] * b[0] + a[1] * b[1]) + (a[2] * b[2] + a[3] * b[3]); }
template <bool FINAL, int W2  > struct EpiFused {
    static constexpr bool PERM = true, AFTER_DRAIN = false, INLOOP_LDS = true;
    static constexpr float w = 0.5f * W2, eps = 1e-6f;
    const bf16_t* xin; const float* rms_in; bf16_t* xn; float* rms_out; float* out; const float* g; int ldc;
    unsigned long long* xbuf;
    unsigned* cnt;
    unsigned* tmo; unsigned code; unsigned poison;
#ifndef EPI_POLL_SLEEP
#define EPI_POLL_SLEEP 4
#endif
    static constexpr unsigned long long SENT = ~0ull;
    static constexpr int LDS_S = 16384, LDS_FLAG = LDS_S + 4096, LDS_G = LDS_FLAG + 64, LDS_END = LDS_G + 4096;
    __device__ __forceinline__ void fill_gains(PG8_LAS unsigned char* lds, int tid) const {
        for (int i = tid; i < 1024; i += 512) ((PG8_LAS float*)(lds + LDS_G))[i] = g[i] * w;
    }
    __device__ __forceinline__ void fused(f32x4 (&acc)[2][2][4][2], const Unit& u, int, int, int, int, PG8_LAS unsigned char* lds, int wid_in, int) const {
        const int wid = opaque_s(wid_in), lane = lane_id(), wr = wid >> 2, wc = wid & 3, fr = lane & 15, fq = lane >> 4;
        PG8_LAS f32x4* P = (PG8_LAS f32x4*)lds;
        PG8_LAS f32x4* S = (PG8_LAS f32x4*)(lds + LDS_S);
        PG8_LAS unsigned* flag = (PG8_LAS unsigned*)(lds + LDS_FLAG);
        const PG8_LAS f32x4* G4 = (const PG8_LAS f32x4*)(lds + LDS_G);
        const int col0 = u.pn * BM + wc * 32 + 8 * fq;
        const PG8_GAS unsigned char* xin_g = (const PG8_GAS unsigned char*)xin; const PG8_GAS float* rms_g = (const PG8_GAS float*)rms_in;
        const int row = wid * 32 + (lane & 31);
        u32x4 bsr[2][4][2];
#define EPIF_LOAD_RES() do { _Pragma("unroll") for (int ai = 0; ai < 2; ++ai) _Pragma("unroll") for (int m = 0; m < 4; ++m) { const int r = ai * HALF + wr * 64 + m * 16 + fr; const unsigned off = (unsigned)((u.pm * BM + r) * ldc + col0) * 2u; \
            _Pragma("unroll") for (int bj = 0; bj < 2; ++bj) bsr[ai][m][bj] = __builtin_nontemporal_load((const PG8_GAS u32x4*)(xin_g + off + (bj * HALF) * 2)); } } while (0)
        if (!FINAL) EPIF_LOAD_RES();
        {
        int gidx = col0 >> 2;
#pragma unroll
        for (int ai = 0; ai < 2; ++ai) {
#pragma unroll
            for (int m = 0; m < 4; ++m) { float sff = 0.f, saa = 0.f, sxx = 0.f, sax = 0.f;
                if (!FINAL) asm volatile("" : "+v"(gidx));
#pragma unroll
                for (int bj = 0; bj < 2; ++bj)
#pragma unroll
                    for (int n = 0; n < 2; ++n) { const f32x4 f = acc[ai][bj][m][n]; sff += dot4(f, f);
                        if (!FINAL) { const f32x4 a = f * G4[gidx + 32 * bj + n]; acc[ai][bj][m][n] = a; const f32x4 xb = (n == 0 ? bf16x4_to_f32(bsr[ai][m][bj].x, bsr[ai][m][bj].y) : bf16x4_to_f32(bsr[ai][m][bj].z, bsr[ai][m][bj].w)); saa += dot4(a, a); sxx += dot4(xb, xb); sax += dot4(a, xb); } }
                sff = xsum32(xsum16(sff));
                if (!FINAL) { saa = xsum32(xsum16(saa)); sxx = xsum32(xsum16(sxx)); sax = xsum32(xsum16(sax)); }
                if (fq == 0) P[(ai * HALF + wr * 64 + m * 16 + fr) * 4 + wc] = (f32x4){sff, saa, sxx, sax};
            }
        }
        }
        const float rinr = *(const PG8_GAS float*)((const PG8_GAS unsigned char*)rms_g + (unsigned)(u.pm * BM + row) * 4u);
        asm volatile("s_waitcnt lgkmcnt(0)" ::: "memory"); __builtin_amdgcn_s_barrier(); asm volatile("" ::: "memory");
        unsigned long long* const slot0 = xbuf + (size_t)u.pm * (8 * BM) + row;
        if (lane < 32) {
            f32x4 t = (P[row * 4 + 0] + P[row * 4 + 1]) + (P[row * 4 + 2] + P[row * 4 + 3]);
            t[2] *= rinr * rinr; t[3] *= rinr;
            unsigned long long w0 = ((unsigned long long)__float_as_uint(t[1]) << 32) | __float_as_uint(t[0]), w1 = ((unsigned long long)__float_as_uint(t[3]) << 32) | __float_as_uint(t[2]);
            if (w0 == SENT) w0 = 0x7fc000007fc00000ull; if (w1 == SENT) w1 = 0x7fc000007fc00000ull;
            __hip_atomic_store(slot0 + (2 * u.pn) * BM, w0, __ATOMIC_RELAXED, __HIP_MEMORY_SCOPE_AGENT);
            __hip_atomic_store(slot0 + (2 * u.pn + 1) * BM, w1, __ATOMIC_RELAXED, __HIP_MEMORY_SCOPE_AGENT);
        }
        if (FINAL) EPIF_LOAD_RES();
#undef EPIF_LOAD_RES
        {
            bool dead = false; unsigned spins = 0u;
            unsigned long long wv[8];
#pragma unroll
            for (int t = 0; t < 8; ++t) wv[t] = 0ull;
            for (;;) {
                bool ok = true;
                if (lane < 32) {
#pragma unroll
                    for (int t = 0; t < 8; ++t) wv[t] = __hip_atomic_load(slot0 + t * BM, __ATOMIC_RELAXED, __HIP_MEMORY_SCOPE_AGENT);
#pragma unroll
                    for (int t = 0; t < 8; ++t) ok = ok && (wv[t] != SENT);
                }
                if (__builtin_amdgcn_ballot_w64(!ok) == 0ull) break;
                if (++spins > 65536u) {
                    if (lane == 0) { unsigned expect = 0u; __hip_atomic_compare_exchange_strong(tmo + 1, &expect, code | (unsigned)(u.pm & 0xff), __ATOMIC_RELAXED, __ATOMIC_RELAXED, __HIP_MEMORY_SCOPE_AGENT);
                                     __hip_atomic_store(tmo, 1u, __ATOMIC_RELAXED, __HIP_MEMORY_SCOPE_AGENT); }
                    dead = true; break; }
                __builtin_amdgcn_s_sleep(EPI_POLL_SLEEP);
            }
            if (dead && lane == 0) flag[0] = 1u;
            if (lane < 32) { float sff = 0.f, saa = 0.f, sbb = 0.f, sab = 0.f;
#pragma unroll
                for (int t = 0; t < 4; ++t) { const unsigned long long w0 = wv[2 * t], w1 = wv[2 * t + 1];
                    sff += __uint_as_float((unsigned)w0); saa += __uint_as_float((unsigned)(w0 >> 32)); sbb += __uint_as_float((unsigned)w1); sab += __uint_as_float((unsigned)(w1 >> 32)); }
                const float r1 = 1.0f / sqrtf(sff * (1.0f / 1024.0f) + eps);
                const float sx = sbb + 2.0f * r1 * sab + (r1 * r1) * saa;
                const float r2 = 1.0f / sqrtf(__builtin_fmaxf(sx, 0.f) * (1.0f / 1024.0f) + eps);
                S[row] = FINAL ? (f32x4){rinr, r1, 0.f, 0.f} : (f32x4){rinr * r2, r1 * r2, 1.0f / r2, 0.f};
            }
        }
        asm volatile("s_waitcnt lgkmcnt(0)" ::: "memory"); __builtin_amdgcn_s_barrier(); asm volatile("" ::: "memory");
        const bool bad = (flag[0] != 0u) || (poison != 0u);
#pragma unroll
        for (int ai = 0; ai < 2; ++ai)
#pragma unroll
            for (int m = 0; m < 4; ++m)
#pragma unroll
                for (int bj = 0; bj < 2; ++bj) asm volatile("" : "+v"(bsr[ai][m][bj]));
        const float qnan = __builtin_nanf("");
        { const int lane2 = lane_id(); const int fr2 = lane2 & 15, fq2 = lane2 >> 4; const int col2 = u.pn * BM + wc * 32 + 8 * fq2;
        const bool rms_writer = (u.pn == 0 && wc == 0 && fq2 == 0);
        int gidx2 = col2 >> 2;
#pragma unroll
        for (int ai = 0; ai < 2; ++ai) {
#pragma unroll
            for (int m = 0; m < 4; ++m) { const int r = ai * HALF + wr * 64 + m * 16 + fr2; const f32x4 cs = S[r];
                if (FINAL) asm volatile("" : "+v"(gidx2)); const unsigned off = (unsigned)((u.pm * BM + r) * ldc + col2);
                if (!FINAL && rms_writer) *(PG8_GAS float*)((PG8_GAS unsigned char*)rms_out + (unsigned)(u.pm * BM + r) * 4u) = cs.z;
#pragma unroll
                for (int bj = 0; bj < 2; ++bj) { u32x4 wv = (u32x4){0u, 0u, 0u, 0u};
#pragma unroll
                    for (int n = 0; n < 2; ++n) { const f32x4 xb = (n == 0 ? bf16x4_to_f32(bsr[ai][m][bj].x, bsr[ai][m][bj].y) : bf16x4_to_f32(bsr[ai][m][bj].z, bsr[ai][m][bj].w)); f32x4 o = xb * cs.x + (FINAL ? acc[ai][bj][m][n] * G4[gidx2 + 32 * bj + n] : acc[ai][bj][m][n]) * cs.y;
                        if (FINAL) { if (bad) o = (f32x4){qnan, qnan, qnan, qnan}; *(PG8_GAS f32x4*)((PG8_GAS unsigned char*)out + (off + bj * HALF + n * 4) * 4u) = o; }
                        else { const unsigned c0 = cvt_pk_bf16(o[0], o[1]), c1 = cvt_pk_bf16(o[2], o[3]); if (n == 0) { wv.x = c0; wv.y = c1; } else { wv.z = c0; wv.w = c1; } } }
                    if (!FINAL) { if (bad) wv = (u32x4){0x7fc07fc0u, 0x7fc07fc0u, 0x7fc07fc0u, 0x7fc07fc0u}; *(PG8_GAS u32x4*)((PG8_GAS unsigned char*)xn + (off + bj * HALF) * 2u) = wv; } }
            }
        }
        }
    }
};

template <class Epi, class Sched, bool ALIGN_EPI = false, bool SP2 = false>
__device__ __forceinline__ void gemm_phase(PG8_LAS unsigned char* lds, const Gemm g, const Sched& S, const Epi& E, const int wave_id  , PG8_LAS unsigned char* epi_lds = nullptr  ) {
    const int lane = lane_id(), wid = opaque_s(wave_id), tid = wid * 64 + lane,
              wr = wid >> 2, wc = wid & 3, fr = lane & 15, fq = lane >> 4;
    const int K = g.K, nt = K / BK;
    unsigned voffA[2], voffB[2];
#pragma unroll
    for (int i = 0; i < 2; ++i) { int R, C; stage_rc(tid * 16 + i * 8192, R, C); const int Rb = Epi::PERM ? ((R & ~31) + perm32(R & 31)) : R;
        voffA[i] = (unsigned)(R * K + C) * 2u; voffB[i] = (unsigned)(Rb * K + C) * 2u; }
    const size_t kstep = (size_t)(BK * 2);
    const size_t hstep = (size_t)HALF * K * 2;
    const size_t tstep = 2 * hstep;
    const unsigned ldsw = (unsigned)wid * 1024u;
    const int aoff = lds_byte(wr * 64 + fr, fq * 8), boff = lds_byte(wc * 32 + fr, fq * 8);
#define PG8_SA(b, h) (((b) * 2 + (h)) * HTB)
#define PG8_SB(b, h) ((4 + (b) * 2 + (h)) * HTB)
#define PG8_STAGE(bufoff, gbase, voff) do { _Pragma("unroll") for (int _i = 0; _i < 2; ++_i) { unsigned _v = (voff)[_i]; if (PG8_OPQ && Epi::INLOOP_LDS) asm volatile("" : "+v"(_v));   \
        __builtin_amdgcn_global_load_lds((const PG8_GAS unsigned*)((const PG8_GAS char*)(gbase) + _v), (PG8_LAS unsigned*)(lds + (bufoff) + ldsw + _i * 8192), 16, 0, PG8_DMA_AUX); } } while (0)
#define PG8_LDA(dst, b, h) do { _Pragma("unroll") for (int m = 0; m < 4; ++m) _Pragma("unroll") for (int k = 0; k < 2; ++k) dst[m][k] = *(const PG8_LAS bf16x8*)(lds + PG8_SA(b, h) + aoff + m * 2048 + k * 1024); } while (0)
#define PG8_LDB(dst, b, h) do { _Pragma("unroll") for (int n = 0; n < 2; ++n) _Pragma("unroll") for (int k = 0; k < 2; ++k) dst[n][k] = *(const PG8_LAS bf16x8*)(lds + PG8_SB(b, h) + boff + n * 2048 + k * 1024); } while (0)
#ifndef PG8_PRIO
#define PG8_PRIO 1
#endif
#ifndef PG8_DMA_AUX
#define PG8_DMA_AUX 1
#endif
#ifndef PG8_OPQ
#define PG8_OPQ 0
#endif
#define PG8_MMA(ai, bj, At, Bt) do { if (PG8_PRIO) __builtin_amdgcn_s_setprio(PG8_PRIO); _Pragma("unroll") for (int m = 0; m < 4; ++m) _Pragma("unroll") for (int n = 0; n < 2; ++n) _Pragma("unroll") for (int k = 0; k < 2; ++k) \
        acc[ai][bj][m][n] = __builtin_amdgcn_mfma_f32_16x16x32_bf16(Bt[n][k], At[m][k], acc[ai][bj][m][n], 0, 0, 0); if (PG8_PRIO) __builtin_amdgcn_s_setprio(0); } while (0)
#define PG8_WAIT_V(n) asm volatile("s_waitcnt vmcnt(" #n ")" ::: "memory")
#define PG8_WAIT_L(n) asm volatile("s_waitcnt lgkmcnt(" #n ")" ::: "memory")
#define PG8_BAR __builtin_amdgcn_s_barrier()
#define PG8_SCHED __builtin_amdgcn_sched_barrier(0)
    Unit cur, nxt; int ui = 0;
    if (!S.next(0, cur)) return;
    f32x4 acc[2][2][4][2];
#pragma unroll
    for (int a = 0; a < 2; ++a)
#pragma unroll
        for (int b = 0; b < 2; ++b)
#pragma unroll
            for (int m = 0; m < 4; ++m)
#pragma unroll
                for (int n = 0; n < 2; ++n) acc[a][b][m][n] = (f32x4){0.f, 0.f, 0.f, 0.f};
    bf16x8 At[4][2], B0[2][2], B1[2][2];
    const char* cA = (const char*)g.A + (size_t)cur.pm * tstep + (size_t)(cur.pm >> 4) * (size_t)g.apad; const char* cB = (const char*)g.Bt + (size_t)cur.pn * tstep;
    S.a_ready(cur);
    if constexpr (SP2) {
        PG8_STAGE(PG8_SB(0, 0), cB, voffB); PG8_STAGE(PG8_SB(0, 1), cB + hstep, voffB); PG8_STAGE(PG8_SA(0, 0), cA, voffA); PG8_STAGE(PG8_SA(0, 1), cA + hstep, voffA);
        if (wr == 1) PG8_BAR;
        PG8_WAIT_V(2); PG8_BAR;
        PG8_STAGE(PG8_SB(1, 0), cB + kstep, voffB); PG8_STAGE(PG8_SB(1, 1), cB + hstep + kstep, voffB);
        PG8_WAIT_V(4); PG8_BAR;
    } else {
        PG8_STAGE(PG8_SB(0, 0), cB, voffB); PG8_STAGE(PG8_SA(0, 0), cA, voffA); PG8_STAGE(PG8_SB(0, 1), cB + hstep, voffB); PG8_STAGE(PG8_SA(0, 1), cA + hstep, voffA);
        if (wr == 1) PG8_BAR;
        PG8_WAIT_V(4); PG8_BAR;
        PG8_STAGE(PG8_SB(1, 0), cB + kstep, voffB); PG8_STAGE(PG8_SA(1, 0), cA + kstep, voffA); PG8_STAGE(PG8_SB(1, 1), cB + hstep + kstep, voffB);
        PG8_WAIT_V(6); PG8_BAR;
    }
    for (;;) {
        const bool has_next = S.next(ui + 1, nxt);
        const char* nA = has_next ? (const char*)g.A + (size_t)nxt.pm * tstep + (size_t)(nxt.pm >> 4) * (size_t)g.apad : cA; const char* nB = has_next ? (const char*)g.Bt + (size_t)nxt.pn * tstep : cB;
        for (int t = 0; t < nt; t += 2) {
            const bool last = (t == nt - 2);
            const char* a1 = cA + (size_t)(t + 1) * kstep;
            const char* a2 = last ? nA : cA + (size_t)(t + 2) * kstep; const char* b2 = last ? nB : cB + (size_t)(t + 2) * kstep;
            const char* a3 = a2 + kstep; const char* b3 = b2 + kstep;
            if (last && has_next) S.a_ready(nxt);
            if constexpr (SP2) {
            PG8_LDB(B0, 0, 0); PG8_LDB(B1, 0, 1); PG8_SCHED; PG8_LDA(At, 0, 0); PG8_STAGE(PG8_SA(1, 0), a1, voffA); PG8_STAGE(PG8_SA(1, 1), a1 + hstep, voffA);
            PG8_WAIT_V(8); PG8_WAIT_L(0); PG8_BAR; PG8_MMA(0, 0, At, B0); PG8_MMA(0, 1, At, B1); PG8_BAR; PG8_SCHED;
            PG8_LDA(At, 0, 1); PG8_STAGE(PG8_SB(0, 0), b2, voffB); PG8_STAGE(PG8_SB(0, 1), b2 + hstep, voffB);
            PG8_WAIT_V(6); PG8_WAIT_L(0); PG8_BAR; PG8_MMA(1, 0, At, B0); PG8_MMA(1, 1, At, B1); PG8_BAR; PG8_SCHED;
            PG8_LDB(B0, 1, 0); PG8_LDB(B1, 1, 1); PG8_SCHED; PG8_LDA(At, 1, 0); PG8_STAGE(PG8_SA(0, 0), a2, voffA); PG8_STAGE(PG8_SA(0, 1), a2 + hstep, voffA);
            PG8_WAIT_V(8); PG8_WAIT_L(0); PG8_BAR; PG8_MMA(0, 0, At, B0); PG8_MMA(0, 1, At, B1); PG8_BAR; PG8_SCHED;
            PG8_LDA(At, 1, 1); PG8_STAGE(PG8_SB(1, 0), b3, voffB); PG8_STAGE(PG8_SB(1, 1), b3 + hstep, voffB);
            PG8_WAIT_V(6); PG8_WAIT_L(0); PG8_BAR; PG8_MMA(1, 0, At, B0); PG8_MMA(1, 1, At, B1); PG8_BAR; PG8_SCHED;
            } else {
            PG8_LDB(B0, 0, 0); PG8_SCHED; PG8_LDA(At, 0, 0); PG8_STAGE(PG8_SA(1, 1), a1 + hstep, voffA);
            PG8_WAIT_L(8); PG8_BAR; PG8_WAIT_L(0); PG8_MMA(0, 0, At, B0); PG8_BAR; PG8_SCHED;
            PG8_LDB(B1, 0, 1); PG8_STAGE(PG8_SB(0, 0), b2, voffB);
            PG8_BAR; PG8_WAIT_L(0); PG8_MMA(0, 1, At, B1); PG8_BAR;
            PG8_LDA(At, 0, 1); PG8_STAGE(PG8_SA(0, 0), a2, voffA);
            PG8_BAR; PG8_WAIT_L(0); PG8_MMA(1, 0, At, B0); PG8_BAR; PG8_SCHED;
            PG8_STAGE(PG8_SB(0, 1), b2 + hstep, voffB);
            PG8_WAIT_V(6); PG8_BAR; PG8_MMA(1, 1, At, B1); PG8_BAR;
            PG8_LDB(B0, 1, 0); PG8_SCHED; PG8_LDA(At, 1, 0); PG8_STAGE(PG8_SA(0, 1), a2 + hstep, voffA);
            PG8_WAIT_L(8); PG8_BAR; PG8_WAIT_L(0); PG8_MMA(0, 0, At, B0); PG8_BAR; PG8_SCHED;
            PG8_LDB(B1, 1, 1); PG8_STAGE(PG8_SB(1, 0), b3, voffB);
            PG8_BAR; PG8_WAIT_L(0); PG8_MMA(0, 1, At, B1); PG8_BAR;
            PG8_LDA(At, 1, 1); PG8_STAGE(PG8_SA(1, 0), a3, voffA);
            PG8_BAR; PG8_WAIT_L(0); PG8_MMA(1, 0, At, B0); PG8_BAR; PG8_SCHED;
            PG8_STAGE(PG8_SB(1, 1), b3 + hstep, voffB);
            PG8_WAIT_V(6); PG8_BAR; PG8_MMA(1, 1, At, B1); PG8_BAR;
            }
        }
        if constexpr (ALIGN_EPI) { if (wr == 0) PG8_BAR; }
        if constexpr (Epi::INLOOP_LDS) { static_assert(ALIGN_EPI, "an in-loop epilogue with workgroup barriers needs both halves aligned"); E.fused(acc, cur, wr, wc, fr, fq, epi_lds, wid, lane); S.done(cur); }
        else if constexpr (!Epi::AFTER_DRAIN) { E(acc, cur, wr, wc, fr, fq); S.done(cur); }
        if (!has_next) break;
#pragma unroll
        for (int a = 0; a < 2; ++a)
#pragma unroll
            for (int b = 0; b < 2; ++b)
#pragma unroll
                for (int m = 0; m < 4; ++m)
#pragma unroll
                    for (int n = 0; n < 2; ++n) acc[a][b][m][n] = (f32x4){0.f, 0.f, 0.f, 0.f};
        cur = nxt; cA = nA; cB = nB; ++ui;
        if constexpr (ALIGN_EPI) { if (wr == 1) PG8_BAR; }
    }
    PG8_WAIT_V(0);
    if constexpr (!ALIGN_EPI) { if (wr == 0) PG8_BAR; }
    PG8_BAR;
    if constexpr (Epi::AFTER_DRAIN) { E.fused(acc, cur, wr, wc, fr, fq, lds, wid, lane); S.done(cur); }
#undef PG8_SA
#undef PG8_SB
#undef PG8_STAGE
#undef PG8_LDA
#undef PG8_LDB
#undef PG8_MMA
#undef PG8_WAIT_V
#undef PG8_WAIT_L
#undef PG8_BAR
#undef PG8_SCHED
}
}

#ifndef PG8_SP2
#define PG8_SP2 true
#endif
#ifndef PG8_ALIGN
#define PG8_ALIGN true
#endif
#include <hip/hip_bf16.h>
#include <cmath>
namespace attn_body {
using bf16=__hip_bfloat16;
using bf16x8=__attribute__((ext_vector_type(8)))short;
using s16x4=__attribute__((ext_vector_type(4)))short;
using f32x16=__attribute__((ext_vector_type(16)))float;
using f32x4=__attribute__((ext_vector_type(4)))float;
using u32x4=__attribute__((ext_vector_type(4)))unsigned;
constexpr int SEQ=2048,D=64,DMQ=3072,DMO=1024;
constexpr int NW=8,QBLK=32,QB=QBLK*NW,KVBLK=64,NQB=SEQ/QB;
__device__ __forceinline__ int crow(int r,int hi){return (r&3)+8*(r>>2)+4*hi;}
#define SBAR() __builtin_amdgcn_sched_barrier(0)
__device__ __forceinline__ void cmask(f32x16&p0,f32x16&p1,int jb,int qrel,int hi){
  const float NEG=-INFINITY; int kb=64*jb+4*hi;
  #pragma unroll
  for(int r=0;r<16;++r){int kv=kb+(r&3)+8*(r>>2); if(kv>qrel)p0[r]=NEG; if(kv+32>qrel)p1[r]=NEG;}
}

constexpr int NSLOT=3, SLOTB=8192;
constexpr int LDS_K=0, LDS_V=NSLOT*SLOTB, LDS_WS=2*NSLOT*SLOTB, LDS_OST=LDS_WS+NW*64*4, LDS_BIAS=LDS_OST+NW*4096+2048, LDS_SCAN=LDS_BIAS+SEQ*4, LDS_BYTES=LDS_SCAN+256;
constexpr float C2=0.125f*1.4426950408889634f;
#ifndef ATTN_DMA_CPOL
#define ATTN_DMA_CPOL ""
#endif
__device__ __forceinline__ void glds16(const void*gsrc,unsigned lds_dst){unsigned keep;
  asm volatile("s_mov_b32 %0, m0\n\ts_mov_b32 m0, %2\n\ts_nop 0\n\tglobal_load_lds_dwordx4 %1, off" ATTN_DMA_CPOL "\n\ts_mov_b32 m0, %0":"=&s"(keep):"v"(gsrc),"s"(lds_dst):"memory");}
__device__ __forceinline__ float max3f(float a,float b,float c){float r;asm("v_max3_f32 %0, %1, %2, %3":"=v"(r):"v"(a),"v"(b),"v"(c));return r;}
__device__ __forceinline__ float max2f(float a,float b){float r;asm("v_max_f32_e32 %0, %1, %2":"=v"(r):"v"(a),"v"(b));return r;}
__device__ __forceinline__ float fadd_s(float a,float b){float r;asm("v_add_f32_e32 %0, %1, %2":"=v"(r):"v"(a),"v"(b));return r;}
__device__ __forceinline__ float fsub_s(float a,float b){float r;asm("v_sub_f32_e32 %0, %1, %2":"=v"(r):"v"(a),"v"(b));return r;}
typedef float f32x2_t __attribute__((ext_vector_type(2))); typedef __bf16 bf16x2_t __attribute__((ext_vector_type(2)));
__device__ __forceinline__ unsigned cvtpk_s(float lo,float hi){f32x2_t v={lo,hi};bf16x2_t b=__builtin_convertvector(v,bf16x2_t);return __builtin_bit_cast(unsigned,b);}
#define WAIT_BAR(N) asm volatile("s_waitcnt vmcnt(" #N ") lgkmcnt(0)\n\ts_barrier":::"memory")

__device__ __forceinline__ void qkt(f32x16&p0,f32x16&p1,const char*Kslot,const bf16x8*qr,const f32x16&negm,int r32,int hi){
  const char*kb=Kslot+hi*1024+r32*16;
  #pragma unroll
  for(int d0=0;d0<4;++d0){
    const bf16x8 b0=*reinterpret_cast<const bf16x8*>(kb+d0*2048);
    const bf16x8 b1=*reinterpret_cast<const bf16x8*>(kb+d0*2048+512);
    if(d0==0){p0=__builtin_amdgcn_mfma_f32_32x32x16_bf16(b0,qr[0],negm,0,0,0);p1=__builtin_amdgcn_mfma_f32_32x32x16_bf16(b1,qr[0],negm,0,0,0);}
    else{p0=__builtin_amdgcn_mfma_f32_32x32x16_bf16(b0,qr[d0],p0,0,0,0);p1=__builtin_amdgcn_mfma_f32_32x32x16_bf16(b1,qr[d0],p1,0,0,0);}}
}
typedef __attribute__((address_space(3))) const char* lds_cptr;
typedef short v4i16_t __attribute__((ext_vector_type(4)));
__device__ __forceinline__ void kload8(bf16x8*kf,lds_cptr kp){
  kf[0]=*(const __attribute__((address_space(3))) bf16x8*)(kp);      kf[1]=*(const __attribute__((address_space(3))) bf16x8*)(kp+512);
  kf[2]=*(const __attribute__((address_space(3))) bf16x8*)(kp+2048); kf[3]=*(const __attribute__((address_space(3))) bf16x8*)(kp+2560);
  kf[4]=*(const __attribute__((address_space(3))) bf16x8*)(kp+4096); kf[5]=*(const __attribute__((address_space(3))) bf16x8*)(kp+4608);
  kf[6]=*(const __attribute__((address_space(3))) bf16x8*)(kp+6144); kf[7]=*(const __attribute__((address_space(3))) bf16x8*)(kp+6656);
}
__device__ __forceinline__ void kload2(bf16x8*kf,lds_cptr kp,int j){ kf[2*j]=*(const __attribute__((address_space(3))) bf16x8*)(kp+j*2048); kf[2*j+1]=*(const __attribute__((address_space(3))) bf16x8*)(kp+j*2048+512); }
__device__ __forceinline__ s16x4 vtr(lds_cptr p){ return __builtin_bit_cast(s16x4,__builtin_amdgcn_ds_read_tr16_b64_v4i16((__attribute__((address_space(3))) v4i16_t*)p)); }
__device__ __forceinline__ float rowmax(const f32x16&p0,const f32x16&p1){
  float a=max3f(p0[0],p0[1],p1[0]),b=max3f(p0[2],p0[3],p1[1]);a=max3f(a,p1[2],p1[3]);
  #pragma unroll
  for(int r=4;r<16;r+=4){a=max3f(a,p0[r],p0[r+1]);b=max3f(b,p0[r+2],p0[r+3]);a=max3f(a,p1[r],p1[r+1]);b=max3f(b,p1[r+2],p1[r+3]);}
  const float m=max2f(a,b);
  auto rr=__builtin_amdgcn_permlane32_swap(__float_as_uint(m),__float_as_uint(m),false,false);
  return max2f(__uint_as_float(rr[0]),__uint_as_float(rr[1]));
}
__device__ __forceinline__ void pv(f32x16*o,int vb,bf16x8 pa0,bf16x8 pa1,bf16x8 pa2,bf16x8 pa3){
  #pragma unroll
  for(int d0=0;d0<2;++d0){s16x4 lo[4],hi[4];
    #pragma unroll
    for(int ks=0;ks<4;++ks){
      asm volatile("ds_read_b64_tr_b16 %0,%1 offset:%c2":"=&v"(lo[ks]):"v"(vb),"i"(d0*4096+ks*1024):"memory");
      asm volatile("ds_read_b64_tr_b16 %0,%1 offset:%c2":"=&v"(hi[ks]):"v"(vb),"i"(d0*4096+ks*1024+512):"memory");}
    asm volatile("s_waitcnt lgkmcnt(0)":::"memory");SBAR();
    #define PK(k) (bf16x8){lo[k][0],lo[k][1],lo[k][2],lo[k][3],hi[k][0],hi[k][1],hi[k][2],hi[k][3]}
    o[d0]=__builtin_amdgcn_mfma_f32_32x32x16_bf16(pa0,PK(0),o[d0],0,0,0);
    o[d0]=__builtin_amdgcn_mfma_f32_32x32x16_bf16(pa1,PK(1),o[d0],0,0,0);
    o[d0]=__builtin_amdgcn_mfma_f32_32x32x16_bf16(pa2,PK(2),o[d0],0,0,0);
    o[d0]=__builtin_amdgcn_mfma_f32_32x32x16_bf16(pa3,PK(3),o[d0],0,0,0);
    #undef PK
  }
}

__device__ __forceinline__ void fox_bias_table(const float*lf,int q0A,int q0B,int q0C,int q0D,char*shm,const int wave_id,const float thr,int&skA,int&skB,int&skC,int&skD){
  const int wid=opaque_s(wave_id),lane=lane_id(),tid=wid*64+lane;
  unsigned lb_=(unsigned)(uintptr_t)shm; asm volatile("":"+v"(lb_));
  typedef __attribute__((address_space(3))) float lf32; typedef __attribute__((address_space(3))) f32x4 lf32x4;
  lf32*tab=(lf32*)(lb_+LDS_BIAS); lf32*wt=(lf32*)(lb_+LDS_SCAN);
  const f32x4 a4_=*(const f32x4*)(lf+4*tid); const float a0=a4_[0],a1=a4_[1],a2=a4_[2],a3=a4_[3];
  const float p1=a0+a1,p2=p1+a2,p3=p2+a3;
  float w=p3;
  #pragma unroll
  for(int o=1;o<64;o<<=1){const float t=shfl_idx_l(w,lane-o); if(lane>=o)w+=t;}
  if(lane==63)wt[wid]=w;
  asm volatile("s_waitcnt lgkmcnt(0)\n\ts_barrier":::"memory");
  float off=0.f;
  #pragma unroll
  for(int j=0;j<8;++j){const float x=wt[j]; if(j<wid)off+=x;}
  const float ex=off+(w-p3);
  const float c0=ex+a0,c1=ex+p1,c2=ex+p2,c3=ex+p3;
  if(4*tid==q0A)wt[8]=c0;
  if(4*tid==q0B)wt[9]=c0;
  if(4*tid==q0C)wt[10]=c0;
  if(4*tid==q0D)wt[11]=c0;
  if((tid&15)==15)wt[16+(tid>>4)]=c3;
  const float L2E=1.4426950408889634f;
  *(lf32x4*)(tab+4*tid)=(f32x4){c0*L2E,c1*L2E,c2*L2E,c3*L2E};
  asm volatile("s_waitcnt lgkmcnt(0)\n\ts_barrier":::"memory");
  const float refA=wt[8],refB=wt[9],refC=wt[10],refD=wt[11];
  int cA=0,cB=0,cC=0,cD=0;
  #pragma unroll
  for(int g=0;g<8;++g){const f32x4 e=*(lf32x4*)(wt+16+4*g);
    #pragma unroll
    for(int i=0;i<4;++i){ if(64*(4*g+i)<q0A&&(e[i]-refA)*L2E>=thr)++cA; if(64*(4*g+i)<q0B&&(e[i]-refB)*L2E>=thr)++cB; if(64*(4*g+i)<q0C&&(e[i]-refC)*L2E>=thr)++cC; if(64*(4*g+i)<q0D&&(e[i]-refD)*L2E>=thr)++cD; } }
  skA=__builtin_amdgcn_readfirstlane(cA&~1); skB=__builtin_amdgcn_readfirstlane(cB&~1); skC=__builtin_amdgcn_readfirstlane(cC&~1); skD=__builtin_amdgcn_readfirstlane(cD&~1);
}

template<int THRL,bool BIAS> __device__ __forceinline__ void attn_unit(int qb,int tskip,const bf16*Qh,const bf16*__restrict__ Kh,const bf16*__restrict__ Vh,bf16*Oh,int mode,float*scr,int sub,float lam,const float*gsub,char*shm,const int wave_id,const bool pre,const bool has_next,const bf16*nKh,const bf16*nVh){
  const int wid=opaque_s(wave_id),lane=lane_id(),r32=lane&31,hi=lane>>5;
  const int q0=qb*QB;
  const bf16*Qw=Qh+(long)(q0+wid*QBLK)*DMQ;
  const unsigned lds0=(unsigned)(uintptr_t)shm;
  float*wsf=(float*)(shm+LDS_WS)+wid*64;
  const bf16*ksrc=Kh+(long)(tskip*KVBLK+lane)*DMQ+wid*8;
  const bf16*vsrc=Vh+(long)(tskip*KVBLK+16*(wid&3)+(lane>>2))*DMQ+(wid>>2)*32+(lane&3)*8;
  const unsigned kdst=lds0+LDS_K+wid*1024, vdst=lds0+LDS_V+wid*1024;
  #define DMA_K(t,slot) glds16(ksrc+(long)(t)*KVBLK*DMQ,(unsigned)__builtin_amdgcn_readfirstlane(kdst+(slot)))
  #define DMA_V(t,slot) glds16(vsrc+(long)(t)*KVBLK*DMQ,(unsigned)__builtin_amdgcn_readfirstlane(vdst+(slot)))
  const int vb0=(int)(lds0+LDS_V)+((lane>>4)&1)*32+(lane&3)*8+(4*hi+((lane&15)>>2))*64;
  const char*Kbase=shm+LDS_K; bf16x8 kf[8];
  const lds_cptr shm3=(lds_cptr)shm; const lds_cptr kp0=shm3+LDS_K+hi*1024+r32*16; const lds_cptr vp0=shm3+LDS_V+((lane>>4)&1)*32+(lane&3)*8+(4*hi+((lane&15)>>2))*64;
  const __attribute__((address_space(3))) float* blp=(const __attribute__((address_space(3))) float*)(shm3+LDS_BIAS)+tskip*KVBLK+4*hi;
  const int NT=(q0+QB)/KVBLK-tskip;
  if(!pre){DMA_K(0,0);DMA_V(0,0);DMA_K(1,SLOTB);}
  bf16x8 qr[4];
  #pragma unroll
  for(int d0=0;d0<4;++d0)qr[d0]=*reinterpret_cast<const bf16x8*>(&Qw[(long)r32*DMQ+d0*16+hi*8]);
  float mhat=0.f,l_reg=0.f;f32x16 o[2];o[0]=f32x16{};o[1]=f32x16{};float z0_=0.f;asm volatile("":"+v"(z0_));f32x16 negm;
  #pragma unroll
  for(int r=0;r<16;++r)negm[r]=z0_;
  asm volatile("":"+v"(negm));
  const int qrel=wid*QBLK+r32;
  #define CMASK(P0,P1,t) do{int jb_=(t)-(NT-4); if(jb_>=0)cmask(P0,P1,jb_,qrel,hi);}while(0)
  #define BIASADD(C0,C1,t) do{ if(BIAS){ const __attribute__((address_space(3))) f32x4* bp_=(const __attribute__((address_space(3))) f32x4*)(blp+(t)*64); \
    _Pragma("unroll") for(int g_=0;g_<4;++g_){ const f32x4 b0_=bp_[2*g_], b1_=bp_[8+2*g_]; \
      C0[4*g_+0]-=b0_[0]; C0[4*g_+1]-=b0_[1]; C0[4*g_+2]-=b0_[2]; C0[4*g_+3]-=b0_[3]; \
      C1[4*g_+0]-=b1_[0]; C1[4*g_+1]-=b1_[1]; C1[4*g_+2]-=b1_[2]; C1[4*g_+3]-=b1_[3]; } } }while(0)
  bool resc=false;
  #define START(P0,P1) do{ const float rm=rowmax(P0,P1); resc=false; \
    { const float dl=rm; mhat=fadd_s(mhat,dl); \
      _Pragma("unroll") for(int r=0;r<16;++r){P0[r]=fsub_s(P0[r],dl);P1[r]=fsub_s(P1[r],dl);} \
      _Pragma("unroll") for(int r=0;r<16;++r)negm[r]=-mhat; asm volatile("":"+v"(negm)); } \
    _Pragma("unroll") for(int r=0;r<16;++r)P0[r]=__builtin_amdgcn_exp2f(P0[r]); }while(0)
  #define RESC() do{ if(resc){ asm volatile("s_waitcnt lgkmcnt(0)":::"memory"); \
      _Pragma("unroll") for(int d_=0;d_<2;++d_) _Pragma("unroll") for(int r=0;r<16;++r)o[d_][r]*=wsf[crow(r,hi)]; } }while(0)
  f32x16 pA0,pA1,pB0,pB1;
  int sl_prev=0,sl_cur=0,sl_next=SLOTB;
  #define ROT() do{sl_prev=sl_cur;sl_cur=sl_next;sl_next=(sl_next==(NSLOT-1)*SLOTB)?0:sl_next+SLOTB;}while(0)
  if(!pre){ DMA_K(2,2*SLOTB);
    WAIT_BAR(3); }
  else { WAIT_BAR(0); }
  qkt(pA0,pA1,Kbase,qr,negm,r32,hi);asm volatile("s_nop 15\n\ts_nop 7":"+v"(pA0),"+v"(pA1));BIASADD(pA0,pA1,0);CMASK(pA0,pA1,0);
  START(pA0,pA1);
  _Pragma("unroll") for(int r=0;r<16;++r)pA1[r]=__builtin_amdgcn_exp2f(pA1[r]);
  WAIT_BAR(0);
  DMA_K(3,0);DMA_V(1,SLOTB);
  ROT();
  kload8(kf,kp0+sl_cur);
  WAIT_BAR(2);
  s16x4 vlo[8],vhi[8]; u32x4 pw0,pw1,pw2,pw3;
  #define PKW(P,B) cvtpk_s(P[B],P[B+1])
  #define PAF(k) __builtin_bit_cast(bf16x8,pw##k)
  #define VFR(i) (bf16x8){vlo[i][0],vlo[i][1],vlo[i][2],vlo[i][3],vhi[i][0],vhi[i][1],vhi[i][2],vhi[i][3]}
  #define PIN(x) asm volatile("":"+v"(x))
  #define MX3(a,b,c) __builtin_fmaxf(__builtin_fmaxf((a),(b)),(c))
  #define GAPA(MF,A0,A1,A2,A3,W0,W1,PW) do{ MF; sacc+=A0; sacc+=A1; sacc+=A2; sacc+=A3; PIN(sacc); W0; W1; PIN(PW); SBAR(); }while(0)
  #define EX(v) __builtin_amdgcn_exp2f(v)
  #define GAPB(MF,X,B) do{ MF; X[B]=EX(X[B]); X[B+1]=EX(X[B+1]); X[B+2]=EX(X[B+2]); X[B+3]=EX(X[B+3]); PIN(X); SBAR(); }while(0)
  #define VRD(i) do{ vlo[i]=vtr(vp_+(((i)>>2)*4096+((i)&3)*1024)); vhi[i]=vtr(vp_+(((i)>>2)*4096+((i)&3)*1024+512)); }while(0)
  #define KRD(G,j) do{ if(G){ kload2(kf,kp0+sl_next,j); SBAR(); } }while(0)
  #define STEP(C0,C1,P0,P1,t,GK,GV,GL) do{ SBAR(); \
    const lds_cptr vp_=vp0+sl_prev; \
    VRD(0); SBAR(); float sacc=(P0[0]+P0[1]); \
    GAPA(C0=__builtin_amdgcn_mfma_f32_32x32x16_bf16(kf[0],qr[0],negm,0,0,0), P0[2],P0[3],P0[4],P0[5],     pw0[0]=PKW(P0,0), pw0[1]=PKW(P0,2), pw0); \
    VRD(4); SBAR(); GAPA(C1=__builtin_amdgcn_mfma_f32_32x32x16_bf16(kf[1],qr[0],negm,0,0,0), P0[6],P0[7],P0[8],P0[9],     pw0[2]=PKW(P0,4), pw0[3]=PKW(P0,6), pw0); \
    VRD(1); SBAR(); GAPA(C0=__builtin_amdgcn_mfma_f32_32x32x16_bf16(kf[2],qr[1],C0,0,0,0),   P0[10],P0[11],P0[12],P0[13], pw1[0]=PKW(P0,8), pw1[1]=PKW(P0,10), pw1); \
    VRD(5); SBAR(); GAPA(C1=__builtin_amdgcn_mfma_f32_32x32x16_bf16(kf[3],qr[1],C1,0,0,0),   P0[14],P0[15],P1[0],P1[1],   pw1[2]=PKW(P0,12),pw1[3]=PKW(P0,14), pw1); \
    VRD(2); SBAR(); GAPA(C0=__builtin_amdgcn_mfma_f32_32x32x16_bf16(kf[4],qr[2],C0,0,0,0),   P1[2],P1[3],P1[4],P1[5],     pw2[0]=PKW(P1,0), pw2[1]=PKW(P1,2), pw2); \
    VRD(6); SBAR(); GAPA(C1=__builtin_amdgcn_mfma_f32_32x32x16_bf16(kf[5],qr[2],C1,0,0,0),   P1[6],P1[7],P1[8],P1[9],     pw2[2]=PKW(P1,4), pw2[3]=PKW(P1,6), pw2); \
    VRD(3); SBAR(); GAPA(C0=__builtin_amdgcn_mfma_f32_32x32x16_bf16(kf[6],qr[3],C0,0,0,0),   P1[10],P1[11],P1[12],P1[13], pw3[0]=PKW(P1,8), pw3[1]=PKW(P1,10), pw3); \
    VRD(7); SBAR(); GAPA(C1=__builtin_amdgcn_mfma_f32_32x32x16_bf16(kf[7],qr[3],C1,0,0,0),   P1[14],P1[15],0.f,0.f,       pw3[2]=PKW(P1,12),pw3[3]=PKW(P1,14), pw3); \
    l_reg+=sacc; \
    if(GK){DMA_K((t)+3,sl_cur);} if(GV){DMA_V((t)+1,sl_next);} \
    BIASADD(C0,C1,t); \
    CMASK(C0,C1,t); \
    { float a=MX3(C0[0],C0[1],C1[0]),b=MX3(C0[2],C0[3],C1[1]); a=MX3(a,C1[2],C1[3]); \
      _Pragma("unroll") for(int r=4;r<16;r+=4){a=MX3(a,C0[r],C0[r+1]);b=MX3(b,C0[r+2],C0[r+3]);a=MX3(a,C1[r],C1[r+1]);b=MX3(b,C1[r+2],C1[r+3]);} \
      float rm=__builtin_fmaxf(a,b); { auto rr=__builtin_amdgcn_permlane32_swap(__float_as_uint(rm),__float_as_uint(rm),false,false); rm=__builtin_fmaxf(__uint_as_float(rr[0]),__uint_as_float(rr[1])); } \
      resc=false; \
      if(__builtin_expect(__any(rm>(float)THRL),0)){ const float dl=__builtin_fmaxf(rm,0.f); mhat+=dl; \
        _Pragma("unroll") for(int r=0;r<16;++r){C0[r]-=dl;C1[r]-=dl;} \
        _Pragma("unroll") for(int r=0;r<16;++r)negm[r]=-mhat; asm volatile("":"+v"(negm)); \
        const float f=__builtin_amdgcn_exp2f(-dl); l_reg*=f; if(hi==0)wsf[r32]=f; resc=true; } } \
    SBAR(); \
    GAPB(o[0]=__builtin_amdgcn_mfma_f32_32x32x16_bf16(PAF(0),VFR(0),o[0],0,0,0), C0,0); \
    GAPB(o[1]=__builtin_amdgcn_mfma_f32_32x32x16_bf16(PAF(0),VFR(4),o[1],0,0,0), C0,4); \
    KRD(GL,0); GAPB(o[0]=__builtin_amdgcn_mfma_f32_32x32x16_bf16(PAF(1),VFR(1),o[0],0,0,0), C0,8); \
    KRD(GL,1); GAPB(o[1]=__builtin_amdgcn_mfma_f32_32x32x16_bf16(PAF(1),VFR(5),o[1],0,0,0), C0,12); \
    KRD(GL,2); GAPB(o[0]=__builtin_amdgcn_mfma_f32_32x32x16_bf16(PAF(2),VFR(2),o[0],0,0,0), C1,0); \
    KRD(GL,3); GAPB(o[1]=__builtin_amdgcn_mfma_f32_32x32x16_bf16(PAF(2),VFR(6),o[1],0,0,0), C1,4); \
    GAPB(o[0]=__builtin_amdgcn_mfma_f32_32x32x16_bf16(PAF(3),VFR(3),o[0],0,0,0), C1,8); \
    GAPB(o[1]=__builtin_amdgcn_mfma_f32_32x32x16_bf16(PAF(3),VFR(7),o[1],0,0,0), C1,12); \
    }while(0)
  int t=1;
  #undef CMASK
  #define CMASK(P0,P1,t) do{}while(0)
  for(;t+5<NT;t+=2){
    STEP(pB0,pB1,pA0,pA1,t,true,true,true);     WAIT_BAR(2); RESC(); ROT();
    STEP(pA0,pA1,pB0,pB1,t+1,true,true,true);   WAIT_BAR(2); RESC(); ROT();
  }
  #undef CMASK
  #define CMASK(P0,P1,t) do{int jb_=(t)-(NT-4); if(jb_>=0)cmask(P0,P1,jb_,qrel,hi);}while(0)
  #define ENDW(tt) do{ if((tt)+3<NT){WAIT_BAR(2);} else if((tt)+2<NT){WAIT_BAR(1);} else {WAIT_BAR(0);} }while(0)
  for(;t+1<NT;t+=2){
    STEP(pB0,pB1,pA0,pA1,t,(t+3<NT),(t+1<NT),(t+1<NT));       ENDW(t);   RESC(); ROT();
    STEP(pA0,pA1,pB0,pB1,t+1,(t+4<NT),(t+2<NT),(t+2<NT));     ENDW(t+1); RESC(); ROT();
  }
  STEP(pB0,pB1,pA0,pA1,NT-1,false,false,false); RESC();
  { float sacc=pB0[0]+pB0[1]; _Pragma("unroll") for(int r=2;r<16;++r)sacc+=pB0[r]; _Pragma("unroll") for(int r=0;r<16;++r)sacc+=pB1[r]; l_reg+=sacc;
    pw0=(u32x4){PKW(pB0,0),PKW(pB0,2),PKW(pB0,4),PKW(pB0,6)};pw1=(u32x4){PKW(pB0,8),PKW(pB0,10),PKW(pB0,12),PKW(pB0,14)};pw2=(u32x4){PKW(pB1,0),PKW(pB1,2),PKW(pB1,4),PKW(pB1,6)};pw3=(u32x4){PKW(pB1,8),PKW(pB1,10),PKW(pB1,12),PKW(pB1,14)};
    SBAR(); pv(o,vb0+sl_cur,PAF(0),PAF(1),PAF(2),PAF(3)); }
  #undef PKW
  #undef PAF
  #undef VFR
  #undef PIN
  #undef MX3
  #undef GAPA
  #undef GAPB
  #undef EX
  #undef VRD
  #undef KRD
  #undef STEP
  #undef ENDW
  asm volatile("s_waitcnt lgkmcnt(0)\n\ts_barrier":::"memory");
  if(has_next){ const bf16*nk=nKh+(long)lane*DMQ+wid*8; const bf16*nv=nVh+(long)(16*(wid&3)+(lane>>2))*DMQ+(wid>>2)*32+(lane&3)*8;
    glds16(nk,(unsigned)__builtin_amdgcn_readfirstlane(kdst)); glds16(nv,(unsigned)__builtin_amdgcn_readfirstlane(vdst));
    glds16(nk+(long)KVBLK*DMQ,(unsigned)__builtin_amdgcn_readfirstlane(kdst+SLOTB)); glds16(nk+(long)2*KVBLK*DMQ,(unsigned)__builtin_amdgcn_readfirstlane(kdst+2*SLOTB)); }
  {auto rr=__builtin_amdgcn_permlane32_swap(__float_as_uint(l_reg),__float_as_uint(l_reg),false,false);l_reg=__uint_as_float(rr[0])+__uint_as_float(rr[1]);}
  if(hi==0)wsf[32+r32]=l_reg;asm volatile("s_waitcnt lgkmcnt(0)":::"memory");
  #pragma unroll
  for(int r=0;r<16;++r){const float rl=__builtin_amdgcn_rcpf(wsf[32+crow(r,hi)]); o[0][r]*=rl; o[1][r]*=rl;}
  if(mode==1){
    float*sp=scr+((size_t)(sub*NW+wid)*32)*64+lane;
    #pragma unroll
    for(int d0=0;d0<2;++d0)
      #pragma unroll
      for(int r=0;r<16;++r)sp[(d0*16+r)*64]=o[d0][r];
  } else {
    bf16*Ow=Oh+(long)(q0+wid*QBLK)*DMO;
    bf16*stg=(bf16*)(shm+LDS_OST)+wid*2048;
    #define OSTAGE(X,COFF) do{ \
      _Pragma("unroll") for(int r=0;r<16;++r){const int orow=crow(r,hi); \
        _Pragma("unroll") for(int d0=0;d0<2;++d0)stg[orow*64+d0*32+r32]=__float2bfloat16(X[d0][r]);} \
      asm volatile("s_waitcnt lgkmcnt(0)":::"memory"); \
      _Pragma("unroll") for(int i=0;i<4;++i){const int row=i*8+(lane>>3),ch=lane&7; const u32x4 v=*(const u32x4*)(stg+row*64+ch*8); *(u32x4*)(Ow+(long)row*DMO+(COFF)+ch*8)=v;} \
      asm volatile("s_waitcnt lgkmcnt(0)":::"memory"); }while(0)
    if(mode==2){
      asm volatile("s_waitcnt vmcnt(0)":::"memory");
      __builtin_amdgcn_fence(__ATOMIC_ACQUIRE,"agent");
      const float*sp=scr+((size_t)wid*32)*64+lane;
      f32x16 e[2]; float ss[16];
      #pragma unroll
      for(int r=0;r<16;++r)ss[r]=0.f;
      #pragma unroll
      for(int d0=0;d0<2;++d0)
        #pragma unroll
        for(int r=0;r<16;++r){
          const float a1v0=sp[((size_t)(0*NW*32)+d0*16+r)*64],a1v1=sp[((size_t)(1*NW*32)+d0*16+r)*64],a2v0=sp[((size_t)(2*NW*32)+d0*16+r)*64];
          const float x0=a1v0-lam*a2v0,x1=a1v1-lam*o[d0][r]; e[d0][r]=x0; o[d0][r]=x1; ss[r]+=x0*x0+x1*x1; }
      #pragma unroll
      for(int r=0;r<16;++r){
        ss[r]=xsum16(rowsum16(ss[r]));
        ss[r]=1.0f/sqrtf(ss[r]*(1.0f/128.0f)+1e-6f); }
      const float g00=gsub[r32]*0.8f,g01=gsub[32+r32]*0.8f,g10=gsub[64+r32]*0.8f,g11=gsub[96+r32]*0.8f;
      #pragma unroll
      for(int r=0;r<16;++r){e[0][r]*=ss[r]*g00; e[1][r]*=ss[r]*g01; o[0][r]*=ss[r]*g10; o[1][r]*=ss[r]*g11;}
      OSTAGE(e,0); OSTAGE(o,64);
    } else { OSTAGE(o,0); }
    #undef OSTAGE
  }
  if(!has_next) asm volatile("s_waitcnt lgkmcnt(0)\n\ts_barrier":::"memory");
  #undef DMA_K
  #undef DMA_V
  #undef CMASK
  #undef BIASADD
  #undef START
  #undef RESC
  #undef ROT
}

constexpr int V2_LDS_K=0, V2_LDS_V=NSLOT*SLOTB, V2_SLOTV=2*SLOTB, V2_LDS_WS=V2_LDS_V+NSLOT*V2_SLOTV, V2_LDS_OST=V2_LDS_WS+NW*64*4, V2_LDS_BYTES=V2_LDS_OST+NW*4096;
template<int THRL> __device__ __forceinline__ void attn_unit128(int qb,const bf16*Qh,const bf16*__restrict__ Kh,const bf16*__restrict__ Vh,bf16*Oh,int mode,float*scr,float lam,const float*gsub,char*shm,const int wave_id,const bool pre,const bool has_next,const bf16*nKh,const bf16*nVh){
  const int wid=opaque_s(wave_id),lane=lane_id(),r32=lane&31,hi=lane>>5;
  const int q0=qb*QB;
  const bf16*Qw=Qh+(long)(q0+wid*QBLK)*DMQ;
  const unsigned lds0=(unsigned)(uintptr_t)shm;
  float*wsf=(float*)(shm+V2_LDS_WS)+wid*64;
  const bf16*ksrc=Kh+(long)lane*DMQ+wid*8;
  const bf16*vsrc=Vh+(long)(16*(wid&3)+(lane>>2))*DMQ+(wid>>2)*32+(lane&3)*8;
  const unsigned kdst=lds0+V2_LDS_K+wid*1024, vdst=lds0+V2_LDS_V+wid*1024;
  #define DMA_K(t,slot) glds16(ksrc+(long)(t)*KVBLK*DMQ,(unsigned)__builtin_amdgcn_readfirstlane(kdst+(slot)))
  #define DMA_V(t,slot) do{ glds16(vsrc+(long)(t)*KVBLK*DMQ,(unsigned)__builtin_amdgcn_readfirstlane(vdst+2*(slot))); glds16(vsrc+(long)(t)*KVBLK*DMQ+64,(unsigned)__builtin_amdgcn_readfirstlane(vdst+2*(slot)+SLOTB)); }while(0)
  const int vb0=(int)(lds0+V2_LDS_V)+((lane>>4)&1)*32+(lane&3)*8+(4*hi+((lane&15)>>2))*64;
  const char*Kbase=shm+V2_LDS_K; bf16x8 kf[8];
  const lds_cptr shm3=(lds_cptr)shm; const lds_cptr kp0=shm3+V2_LDS_K+hi*1024+r32*16; const lds_cptr vp0=shm3+V2_LDS_V+((lane>>4)&1)*32+(lane&3)*8+(4*hi+((lane&15)>>2))*64;
  const int NT=(q0+QB)/KVBLK;
  if(!pre){DMA_K(0,0);DMA_V(0,0);DMA_K(1,SLOTB);}
  bf16x8 qr[4];
  #pragma unroll
  for(int d0=0;d0<4;++d0)qr[d0]=*reinterpret_cast<const bf16x8*>(&Qw[(long)r32*DMQ+d0*16+hi*8]);
  float mhat=0.f,l_reg=0.f;f32x16 o[4];o[0]=f32x16{};o[1]=f32x16{};o[2]=f32x16{};o[3]=f32x16{};
  const int qrel=wid*QBLK+r32;
  #define CMASK(P0,P1,t) do{int jb_=(t)-(NT-4); if(jb_>=0)cmask(P0,P1,jb_,qrel,hi);}while(0)
  bool resc=false;
  #define RESC() do{ if(resc){ asm volatile("s_waitcnt lgkmcnt(0)":::"memory"); \
      _Pragma("unroll") for(int d_=0;d_<4;++d_) _Pragma("unroll") for(int r=0;r<16;++r)o[d_][r]*=wsf[crow(r,hi)]; } }while(0)
  f32x16 pA0,pA1,pB0,pB1;
  int sl_prev=0,sl_cur=0,sl_next=SLOTB;
  #define ROT() do{sl_prev=sl_cur;sl_cur=sl_next;sl_next=(sl_next==(NSLOT-1)*SLOTB)?0:sl_next+SLOTB;}while(0)
  if(!pre){ DMA_K(2,2*SLOTB);
    WAIT_BAR(4); }
  else { WAIT_BAR(0); }
  { f32x16 z16; float z0_=0.f; asm volatile("":"+v"(z0_));
    #pragma unroll
    for(int r=0;r<16;++r)z16[r]=z0_;
    qkt(pA0,pA1,Kbase,qr,z16,r32,hi); }
  asm volatile("s_nop 15\n\ts_nop 7":"+v"(pA0),"+v"(pA1));
  CMASK(pA0,pA1,0);
  { const float rm=rowmax(pA0,pA1); mhat=rm;
    #pragma unroll
    for(int r=0;r<16;++r){pA0[r]=__builtin_amdgcn_exp2f(pA0[r]-rm);pA1[r]=__builtin_amdgcn_exp2f(pA1[r]-rm);} }
  WAIT_BAR(0);
  DMA_K(3,0);DMA_V(1,SLOTB);
  ROT();
  kload8(kf,kp0+sl_cur);
  WAIT_BAR(3);
  s16x4 vlo[8],vhi[8],wlo[8],whi[8]; u32x4 pw0,pw1,pw2,pw3;
  #define PKW(P,B) cvtpk_s(P[B],P[B+1])
  #define PAF(k) __builtin_bit_cast(bf16x8,pw##k)
  #define VFR(i) (bf16x8){vlo[i][0],vlo[i][1],vlo[i][2],vlo[i][3],vhi[i][0],vhi[i][1],vhi[i][2],vhi[i][3]}
  #define WFR(i) (bf16x8){wlo[i][0],wlo[i][1],wlo[i][2],wlo[i][3],whi[i][0],whi[i][1],whi[i][2],whi[i][3]}
  #define PIN(x) asm volatile("":"+v"(x))
  #define MX3(a,b,c) __builtin_fmaxf(__builtin_fmaxf((a),(b)),(c))
  #define GAPA(MF,A0,A1,A2,A3,W0,W1,PW) do{ MF; sacc+=A0; sacc+=A1; sacc+=A2; sacc+=A3; PIN(sacc); W0; W1; PIN(PW); SBAR(); }while(0)
  #define EX(v) __builtin_amdgcn_exp2f(v)
  #define GAPB(MF,X,B) do{ MF; X[B]=EX(X[B]); X[B+1]=EX(X[B+1]); PIN(X); SBAR(); }while(0)
  #define VRD(i) do{ vlo[i]=vtr(vp_+(((i)>>2)*4096+((i)&3)*1024)); vhi[i]=vtr(vp_+(((i)>>2)*4096+((i)&3)*1024+512)); }while(0)
  #define WRD(i) do{ wlo[i]=vtr(vp_+(8192+((i)>>2)*4096+((i)&3)*1024)); whi[i]=vtr(vp_+(8192+((i)>>2)*4096+((i)&3)*1024+512)); SBAR(); }while(0)
  #define KRD(G,j) do{ if(G){ kload2(kf,kp0+sl_next,j); SBAR(); } }while(0)
  #define STEP(C0,C1,P0,P1,t,GK,GV,GL) do{ SBAR(); \
    const lds_cptr vp_=vp0+2*sl_prev; \
    { const float nm_=-mhat; _Pragma("unroll") for(int r=0;r<16;++r){C0[r]=nm_;C1[r]=nm_;} } PIN(C0); PIN(C1); SBAR(); \
    VRD(0); SBAR(); float sacc=(P0[0]+P0[1]); \
    GAPA(C0=__builtin_amdgcn_mfma_f32_32x32x16_bf16(kf[0],qr[0],C0,0,0,0), P0[2],P0[3],P0[4],P0[5],     pw0[0]=PKW(P0,0), pw0[1]=PKW(P0,2), pw0); \
    VRD(4); SBAR(); GAPA(C1=__builtin_amdgcn_mfma_f32_32x32x16_bf16(kf[1],qr[0],C1,0,0,0), P0[6],P0[7],P0[8],P0[9],     pw0[2]=PKW(P0,4), pw0[3]=PKW(P0,6), pw0); \
    VRD(1); SBAR(); GAPA(C0=__builtin_amdgcn_mfma_f32_32x32x16_bf16(kf[2],qr[1],C0,0,0,0),   P0[10],P0[11],P0[12],P0[13], pw1[0]=PKW(P0,8), pw1[1]=PKW(P0,10), pw1); \
    VRD(5); SBAR(); GAPA(C1=__builtin_amdgcn_mfma_f32_32x32x16_bf16(kf[3],qr[1],C1,0,0,0),   P0[14],P0[15],P1[0],P1[1],   pw1[2]=PKW(P0,12),pw1[3]=PKW(P0,14), pw1); \
    VRD(2); SBAR(); GAPA(C0=__builtin_amdgcn_mfma_f32_32x32x16_bf16(kf[4],qr[2],C0,0,0,0),   P1[2],P1[3],P1[4],P1[5],     pw2[0]=PKW(P1,0), pw2[1]=PKW(P1,2), pw2); \
    VRD(6); SBAR(); GAPA(C1=__builtin_amdgcn_mfma_f32_32x32x16_bf16(kf[5],qr[2],C1,0,0,0),   P1[6],P1[7],P1[8],P1[9],     pw2[2]=PKW(P1,4), pw2[3]=PKW(P1,6), pw2); \
    VRD(3); SBAR(); GAPA(C0=__builtin_amdgcn_mfma_f32_32x32x16_bf16(kf[6],qr[3],C0,0,0,0),   P1[10],P1[11],P1[12],P1[13], pw3[0]=PKW(P1,8), pw3[1]=PKW(P1,10), pw3); \
    VRD(7); SBAR(); GAPA(C1=__builtin_amdgcn_mfma_f32_32x32x16_bf16(kf[7],qr[3],C1,0,0,0),   P1[14],P1[15],0.f,0.f,       pw3[2]=PKW(P1,12),pw3[3]=PKW(P1,14), pw3); \
    l_reg+=sacc; \
    if(GK){DMA_K((t)+3,sl_cur);} if(GV){DMA_V((t)+1,sl_next);} \
    CMASK(C0,C1,t); \
    { float a=MX3(C0[0],C0[1],C1[0]),b=MX3(C0[2],C0[3],C1[1]); a=MX3(a,C1[2],C1[3]); \
      _Pragma("unroll") for(int r=4;r<16;r+=4){a=MX3(a,C0[r],C0[r+1]);b=MX3(b,C0[r+2],C0[r+3]);a=MX3(a,C1[r],C1[r+1]);b=MX3(b,C1[r+2],C1[r+3]);} \
      float rm=__builtin_fmaxf(a,b); { auto rr=__builtin_amdgcn_permlane32_swap(__float_as_uint(rm),__float_as_uint(rm),false,false); rm=__builtin_fmaxf(__uint_as_float(rr[0]),__uint_as_float(rr[1])); } \
      resc=false; \
      if(__builtin_expect(__any(rm>(float)THRL),0)){ const float dl=__builtin_fmaxf(rm,0.f); mhat+=dl; \
        _Pragma("unroll") for(int r=0;r<16;++r){C0[r]-=dl;C1[r]-=dl;} \
        const float f=__builtin_amdgcn_exp2f(-dl); l_reg*=f; if(hi==0)wsf[r32]=f; resc=true; } } \
    SBAR(); \
    GAPB(o[0]=__builtin_amdgcn_mfma_f32_32x32x16_bf16(PAF(0),VFR(0),o[0],0,0,0), C0,0);  WRD(0); \
    GAPB(o[1]=__builtin_amdgcn_mfma_f32_32x32x16_bf16(PAF(0),VFR(4),o[1],0,0,0), C0,2);  WRD(4); \
    GAPB(o[0]=__builtin_amdgcn_mfma_f32_32x32x16_bf16(PAF(1),VFR(1),o[0],0,0,0), C0,4);  WRD(1); \
    GAPB(o[1]=__builtin_amdgcn_mfma_f32_32x32x16_bf16(PAF(1),VFR(5),o[1],0,0,0), C0,6);  WRD(5); \
    GAPB(o[0]=__builtin_amdgcn_mfma_f32_32x32x16_bf16(PAF(2),VFR(2),o[0],0,0,0), C0,8);  WRD(2); \
    GAPB(o[1]=__builtin_amdgcn_mfma_f32_32x32x16_bf16(PAF(2),VFR(6),o[1],0,0,0), C0,10); WRD(6); \
    GAPB(o[0]=__builtin_amdgcn_mfma_f32_32x32x16_bf16(PAF(3),VFR(3),o[0],0,0,0), C0,12); WRD(3); \
    GAPB(o[1]=__builtin_amdgcn_mfma_f32_32x32x16_bf16(PAF(3),VFR(7),o[1],0,0,0), C0,14); WRD(7); \
    GAPB(o[2]=__builtin_amdgcn_mfma_f32_32x32x16_bf16(PAF(0),WFR(0),o[2],0,0,0), C1,0); \
    GAPB(o[3]=__builtin_amdgcn_mfma_f32_32x32x16_bf16(PAF(0),WFR(4),o[3],0,0,0), C1,2); \
    KRD(GL,0); GAPB(o[2]=__builtin_amdgcn_mfma_f32_32x32x16_bf16(PAF(1),WFR(1),o[2],0,0,0), C1,4); \
    KRD(GL,1); GAPB(o[3]=__builtin_amdgcn_mfma_f32_32x32x16_bf16(PAF(1),WFR(5),o[3],0,0,0), C1,6); \
    KRD(GL,2); GAPB(o[2]=__builtin_amdgcn_mfma_f32_32x32x16_bf16(PAF(2),WFR(2),o[2],0,0,0), C1,8); \
    KRD(GL,3); GAPB(o[3]=__builtin_amdgcn_mfma_f32_32x32x16_bf16(PAF(2),WFR(6),o[3],0,0,0), C1,10); \
    GAPB(o[2]=__builtin_amdgcn_mfma_f32_32x32x16_bf16(PAF(3),WFR(3),o[2],0,0,0), C1,12); \
    GAPB(o[3]=__builtin_amdgcn_mfma_f32_32x32x16_bf16(PAF(3),WFR(7),o[3],0,0,0), C1,14); \
    }while(0)
  int t=1;
  #undef CMASK
  #define CMASK(P0,P1,t) do{}while(0)
  for(;t+5<NT;t+=2){
    STEP(pB0,pB1,pA0,pA1,t,true,true,true);     WAIT_BAR(3); RESC(); ROT();
    STEP(pA0,pA1,pB0,pB1,t+1,true,true,true);   WAIT_BAR(3); RESC(); ROT();
  }
  #undef CMASK
  #define CMASK(P0,P1,t) do{int jb_=(t)-(NT-4); if(jb_>=0)cmask(P0,P1,jb_,qrel,hi);}while(0)
  #define ENDW(tt) do{ if((tt)+3<NT){WAIT_BAR(3);} else if((tt)+2<NT){WAIT_BAR(2);} else {WAIT_BAR(0);} }while(0)
  for(;t+1<NT;t+=2){
    STEP(pB0,pB1,pA0,pA1,t,(t+3<NT),(t+1<NT),(t+1<NT));       ENDW(t);   RESC(); ROT();
    STEP(pA0,pA1,pB0,pB1,t+1,(t+4<NT),(t+2<NT),(t+2<NT));     ENDW(t+1); RESC(); ROT();
  }
  STEP(pB0,pB1,pA0,pA1,NT-1,false,false,false); RESC();
  { float sacc=pB0[0]+pB0[1]; _Pragma("unroll") for(int r=2;r<16;++r)sacc+=pB0[r]; _Pragma("unroll") for(int r=0;r<16;++r)sacc+=pB1[r]; l_reg+=sacc;
    pw0=(u32x4){PKW(pB0,0),PKW(pB0,2),PKW(pB0,4),PKW(pB0,6)};pw1=(u32x4){PKW(pB0,8),PKW(pB0,10),PKW(pB0,12),PKW(pB0,14)};pw2=(u32x4){PKW(pB1,0),PKW(pB1,2),PKW(pB1,4),PKW(pB1,6)};pw3=(u32x4){PKW(pB1,8),PKW(pB1,10),PKW(pB1,12),PKW(pB1,14)};
    SBAR(); pv(o,vb0+2*sl_cur,PAF(0),PAF(1),PAF(2),PAF(3)); pv(o+2,vb0+2*sl_cur+SLOTB,PAF(0),PAF(1),PAF(2),PAF(3)); }
  #undef PKW
  #undef PAF
  #undef VFR
  #undef WFR
  #undef PIN
  #undef MX3
  #undef GAPA
  #undef GAPB
  #undef EX
  #undef VRD
  #undef WRD
  #undef KRD
  #undef STEP
  #undef ENDW
  asm volatile("s_waitcnt lgkmcnt(0)\n\ts_barrier":::"memory");
  if(has_next){ const bf16*nk=nKh+(long)lane*DMQ+wid*8; const bf16*nv=nVh+(long)(16*(wid&3)+(lane>>2))*DMQ+(wid>>2)*32+(lane&3)*8;
    glds16(nk,(unsigned)__builtin_amdgcn_readfirstlane(kdst)); glds16(nv,(unsigned)__builtin_amdgcn_readfirstlane(vdst)); glds16(nv+64,(unsigned)__builtin_amdgcn_readfirstlane(vdst+SLOTB));
    glds16(nk+(long)KVBLK*DMQ,(unsigned)__builtin_amdgcn_readfirstlane(kdst+SLOTB)); glds16(nk+(long)2*KVBLK*DMQ,(unsigned)__builtin_amdgcn_readfirstlane(kdst+2*SLOTB)); }
  {auto rr=__builtin_amdgcn_permlane32_swap(__float_as_uint(l_reg),__float_as_uint(l_reg),false,false);l_reg=__uint_as_float(rr[0])+__uint_as_float(rr[1]);}
  if(hi==0)wsf[32+r32]=l_reg;asm volatile("s_waitcnt lgkmcnt(0)":::"memory");
  #pragma unroll
  for(int r=0;r<16;++r){const float rl=__builtin_amdgcn_rcpf(wsf[32+crow(r,hi)]); o[0][r]*=rl; o[1][r]*=rl; o[2][r]*=rl; o[3][r]*=rl;}
  f32x4*sp=(f32x4*)scr+((size_t)wid*16)*64+lane;
  if(mode==1){
    #pragma unroll
    for(int d0=0;d0<4;++d0)
      #pragma unroll
      for(int rq=0;rq<4;++rq)sp[(d0*4+rq)*64]=(f32x4){o[d0][4*rq],o[d0][4*rq+1],o[d0][4*rq+2],o[d0][4*rq+3]};
  } else {
    bf16*Ow=Oh+(long)(q0+wid*QBLK)*DMO;
    bf16*stg=(bf16*)(shm+V2_LDS_OST)+wid*2048;
    float ss[16];
    #pragma unroll
    for(int r=0;r<16;++r)ss[r]=0.f;
    #pragma unroll
    for(int d0=0;d0<4;++d0)
      #pragma unroll
      for(int rq=0;rq<4;++rq){ const f32x4 a4=__builtin_nontemporal_load(sp+(d0*4+rq)*64);
        #pragma unroll
        for(int i=0;i<4;++i){ const int r=4*rq+i; const float x=a4[i]-lam*o[d0][r]; o[d0][r]=x; ss[r]+=x*x; } }
    #pragma unroll
    for(int r=0;r<16;++r){
      ss[r]=xsum16(rowsum16(ss[r]));
      ss[r]=1.0f/sqrtf(ss[r]*(1.0f/128.0f)+1e-6f); }
    const float g0=gsub[r32]*0.8f,g1=gsub[32+r32]*0.8f,g2=gsub[64+r32]*0.8f,g3=gsub[96+r32]*0.8f;
    #pragma unroll
    for(int r=0;r<16;++r){o[0][r]*=ss[r]*g0; o[1][r]*=ss[r]*g1; o[2][r]*=ss[r]*g2; o[3][r]*=ss[r]*g3;}
    #define OSTAGE(X0,X1,COFF) do{ \
      _Pragma("unroll") for(int r=0;r<16;++r){const int orow=crow(r,hi); stg[orow*64+r32]=__float2bfloat16(X0[r]); stg[orow*64+32+r32]=__float2bfloat16(X1[r]);} \
      asm volatile("s_waitcnt lgkmcnt(0)":::"memory"); \
      _Pragma("unroll") for(int i=0;i<4;++i){const int row=i*8+(lane>>3),ch=lane&7; const u32x4 v=*(const u32x4*)(stg+row*64+ch*8); *(u32x4*)(Ow+(long)row*DMO+(COFF)+ch*8)=v;} \
      asm volatile("s_waitcnt lgkmcnt(0)":::"memory"); }while(0)
    OSTAGE(o[0],o[1],0); OSTAGE(o[2],o[3],64);
    #undef OSTAGE
  }
  if(!has_next) asm volatile("s_waitcnt lgkmcnt(0)\n\ts_barrier":::"memory");
  #undef DMA_K
  #undef DMA_V
  #undef CMASK
  #undef RESC
  #undef ROT
}
static_assert(V2_LDS_BYTES<=131072,"value-128 attention LDS");

constexpr int ATTN_LDS_BYTES=LDS_BYTES;
#undef SBAR
#undef WAIT_BAR
}

constexpr int NWAVES = 8;
#ifndef MK_N_LAUNCHES
#define MK_N_LAUNCHES 1
#endif
constexpr int PER_PHASE = 8;
constexpr int N_LAUNCHES = MK_N_LAUNCHES;
static_assert(N_LAUNCHES == 1 || N_LAUNCHES == PER_PHASE, "MK_N_LAUNCHES is 1 or 8");

constexpr int BATCH = 16, SEQ = 2048, D = 1024, FF = 2816, NGU = 2 * FF, NIN = 3072, NIN_SRC = 3080;
constexpr int M = BATCH * SEQ;
constexpr int MH = M / 2;
constexpr float RMS_EPS = 1e-6f;

constexpr size_t MiB = 1u << 20;
constexpr size_t WS_CTL = 0, CTL_ZERO_BYTES = 320 * 1024;
constexpr size_t WS_WGU1 = 2 * MiB, WS_WD1 = 14 * MiB, WS_WIN = 20 * MiB, WS_WOUT = 26 * MiB, WS_WGU2 = 28 * MiB, WS_WD2 = 40 * MiB;
constexpr size_t WS_ROPE = 46 * MiB;
constexpr size_t WS_X = 48 * MiB, X_BYTES = 2 * MiB;
constexpr size_t WS_LOGF = 56 * MiB;
constexpr size_t WS_RMS0 = 58 * MiB, WS_RMS1 = 59 * MiB, WS_RMS2 = 60 * MiB;
constexpr size_t WS_XN = 64 * MiB;
constexpr size_t WS_MIX = 128 * MiB;
constexpr size_t WS_H = 192 * MiB;
constexpr size_t WS_QKV = 192 * MiB;
constexpr size_t H_PAD = (size_t)4096 * (NIN - FF) * 2;
static_assert(H_PAD == 2 * MiB, "h chunk pad");
constexpr size_t WS_SCR = 384 * MiB, SCR_PER_CU = 3 * 8 * 2 * 16 * 64 * 4;
constexpr size_t WS_END = 432 * MiB;
static_assert(WS_WGU1 + (size_t)NGU * D * 2 <= WS_WD1 && WS_WD1 + (size_t)D * FF * 2 <= WS_WIN && WS_WIN + (size_t)NIN * D * 2 <= WS_WOUT && WS_WOUT + (size_t)D * D * 2 <= WS_WGU2 &&
              WS_WGU2 + (size_t)NGU * D * 2 <= WS_WD2 && WS_WD2 + (size_t)D * FF * 2 <= WS_ROPE && WS_ROPE + (size_t)SEQ * 16 * 4 <= WS_X && WS_X + 3 * X_BYTES <= WS_LOGF &&
              WS_LOGF + (size_t)M * 8 * 4 <= WS_XN && WS_XN + (size_t)M * D * 2 <= WS_MIX && WS_MIX + (size_t)M * D * 2 <= WS_H && WS_H + (size_t)M * FF * 2 + 8 * H_PAD <= WS_SCR &&
              WS_QKV + (size_t)M * NIN * 2 <= WS_SCR && WS_SCR + 256 * SCR_PER_CU <= WS_END, "d_ws map");
constexpr int CW_TMO = 0, CW_CODE = 1;
constexpr int CW_XMIS = 64;
constexpr int CW_BAR = 4096;
constexpr int CW_SEAM = 16384, SEAM_BANK = 128 * 64;
constexpr int CW_STAT = 65536;
enum SeamBank { SB_A = 0, SB_B = 1, SB_C = 2, SB_N = 3 };
static_assert((CW_SEAM + SB_N * SEAM_BANK) * 4 <= (int)CTL_ZERO_BYTES, "CTL words inside the memset region");

constexpr int RING_OFF = 0, RING_BYTES = 131072;
constexpr int LDSCTL_OFF = RING_BYTES, MISC_OFF = LDSCTL_OFF + 320;
constexpr int EPI_OFF = LDSCTL_OFF + 1024, EPI_BYTES = 16384 + 4096 + 64 + 4096;
constexpr int LDS_BYTES = 157696;
static_assert(MISC_OFF + 128 <= EPI_OFF && EPI_OFF + EPI_BYTES <= LDS_BYTES, "LDS map");

#define GAS __attribute__((address_space(1)))
#define LAS __attribute__((address_space(3)))
typedef unsigned short bf16;
typedef unsigned v4u __attribute__((ext_vector_type(4)));
typedef float f32x4 __attribute__((ext_vector_type(4)));
typedef short bf16x8 __attribute__((ext_vector_type(8)));
typedef GAS unsigned gu32;
typedef GAS unsigned long long gu64;
#define RLX_AGENT __ATOMIC_RELAXED, __HIP_MEMORY_SCOPE_AGENT
#define LDS_WAIT() asm volatile("s_waitcnt lgkmcnt(0)" ::: "memory")
#define VM_WAIT() asm volatile("s_waitcnt vmcnt(0)" ::: "memory")
__device__ __forceinline__ unsigned long long rt() { return __builtin_amdgcn_s_memrealtime(); }
__device__ __forceinline__ unsigned f2bf(float f) { unsigned u = __builtin_bit_cast(unsigned, f); return (u + 0x7fffu + ((u >> 16) & 1u)) >> 16; }
__device__ __forceinline__ unsigned pk2(float lo, float hi) { return f2bf(lo) | (f2bf(hi) << 16); }

#define XB_TMO      128
#define XB_XCNT(j)  (256  + 64 * (j))
#define XB_XSUB(j)  (1280 + 64 * (j))
#define XB_XGEN(j)  (2304 + 64 * (j))
#define XB_TOP      3328
#define XB_TOPGEN   3392
#define XCD_BAR_WORDS 3456
#define XB_SPIN_CAP (1u << 18)

__device__ __forceinline__ unsigned xb_ld(unsigned* p)              { return __hip_atomic_load(p, __ATOMIC_RELAXED, __HIP_MEMORY_SCOPE_AGENT); }
__device__ __forceinline__ unsigned xb_add(unsigned* p, unsigned v) { return __hip_atomic_fetch_add(p, v, __ATOMIC_RELAXED, __HIP_MEMORY_SCOPE_AGENT); }
__device__ __forceinline__ unsigned xb_xcc_id() { return (unsigned)__builtin_amdgcn_s_getreg((3 << 11) | 20) & 0xFu; }
#define XB_SPIN(cond, bar) do { unsigned _sp = 0; while (cond) { __builtin_amdgcn_s_sleep(1); \
    if ((++_sp & 255u) == 0u) { if (xb_ld(&(bar)[XB_TMO])) break; if (_sp > XB_SPIN_CAP) { atomicAdd(&(bar)[XB_TMO], 1u); break; } } } } while (0)

struct XcdBarrier {
    unsigned* bar; unsigned x; int wave;
    volatile LAS unsigned* st;
};

__device__ __forceinline__ XcdBarrier xcd_barrier_post(unsigned* bar, volatile LAS unsigned* st, int wave) {
    XcdBarrier b; b.bar = bar; b.x = xb_xcc_id(); b.st = st; b.wave = wave;
    if (wave == 0 && lane_id() == 0) (void)xb_add(&bar[XB_XCNT(b.x)], 1u);
    return b;
}
__device__ __forceinline__ void xcd_barrier_complete(unsigned* bar, unsigned x, unsigned& nloc, unsigned& nx) {
    const unsigned G = gridDim.x * gridDim.y * gridDim.z;
    unsigned sum, cnt, mine, sp = 0u;
    for (;;) {
        sum = 0u; cnt = 0u; mine = 0u;
#pragma unroll
        for (unsigned j = 0; j < 16; ++j) { const unsigned c = xb_ld(&bar[XB_XCNT(j)]); sum += c; cnt += (c > 0u) ? 1u : 0u; mine = (j == x) ? c : mine; }
        if (sum == G) break;
        __builtin_amdgcn_s_sleep(1);
        if ((++sp & 255u) == 0u) { if (xb_ld(&bar[XB_TMO])) break; if (sp > XB_SPIN_CAP) { atomicAdd(&bar[XB_TMO], 1u); break; } }
    }
    nloc = mine > 0u ? mine : 1u; nx = cnt > 0u ? cnt : 1u;
}

__device__ __forceinline__ void xcd_barrier(const XcdBarrier& b, const bool loc = false) {
    asm volatile("s_waitcnt vmcnt(0)" ::: "memory");
    __syncthreads();
    if (b.wave == 0 && lane_id() == 0) {
        unsigned* bar = b.bar;
        __builtin_amdgcn_s_waitcnt(0);
        unsigned nloc = b.st[0], nx = b.st[1];
        if (nloc == 0u) { xcd_barrier_complete(bar, b.x, nloc, nx); b.st[0] = nloc; b.st[1] = nx; }
        const unsigned old = xb_add(&bar[XB_XSUB(b.x)], 1u);
        const unsigned gen = old / nloc;
        if (old + 1u == (gen + 1u) * nloc) {
            if (loc) { asm volatile("buffer_inv sc1" ::: "memory"); }
            else {
            __builtin_amdgcn_fence(__ATOMIC_RELEASE, "agent");
            asm volatile("s_waitcnt vmcnt(0)" ::: "memory");
            const unsigned og = xb_add(&bar[XB_TOP], 1u);
            const unsigned tg = og / nx;
            asm volatile("buffer_inv sc1" ::: "memory");
            if (og + 1u == (tg + 1u) * nx) xb_add(&bar[XB_TOPGEN], 1u);
            else XB_SPIN(xb_ld(&bar[XB_TOPGEN]) == tg, bar);
            }
            asm volatile("" ::: "memory");
            xb_add(&bar[XB_XGEN(b.x)], 1u);
            asm volatile("s_waitcnt vmcnt(0)" ::: "memory");
        } else {
            asm volatile("buffer_inv sc1" ::: "memory");
            XB_SPIN(xb_ld(&bar[XB_XGEN(b.x)]) == gen, bar);
            asm volatile("" ::: "memory");
            asm volatile("s_waitcnt vmcnt(0)" ::: "memory");
        }
    }
    __syncthreads();
}

struct Frame {
    LAS unsigned char* lds;
    volatile LAS unsigned* MISC;
    gu32* ctl;
    int wave;
    int vcu, G;
};
__device__ __forceinline__ gu32* seam_word(Frame& F, int bank, int pm) { return F.ctl + CW_SEAM + bank * SEAM_BANK + 64 * pm; }

__device__ __forceinline__ float wave_sum(float v) {
    const int lane = lane_id();
#pragma unroll
    for (int o = 1; o < 64; o <<= 1) v += shfl_xor_l(v, o, lane);
    return v;
}
__device__ __forceinline__ int w_drow(int mode, int n) {
    if (mode == 1) return 256 * (n >> 7) + (n & 127);
    if (mode == 2) return 256 * (n >> 7) + 128 + (n & 127);
    if (mode == 4) { const int c = 1536 + n; if (c < 2560) { const int d = c & 63; const int p = (d >= 4 && d < 8) ? d + 4 : ((d >= 8 && d < 12) ? d - 4 : d); return (c & ~63) + p; } return c; }
    return n;
}
__device__ __forceinline__ void p0_transpose_item(const float* W, int ldw, int K, int N, bf16* WT, int mode, LAS float* scr, int item, int lane, const float* gain  ) {
    const int nblk = N / 32, kb = item / nblk, nb = item % nblk, k0 = 64 * kb, n0 = 32 * nb;
    const float wscale = (mode == 1) ? -1.4426950408889634f : (mode == 2) ? -0.6931471805599453f : 1.f;
    f32x4 v[8];
#pragma unroll
    for (int i = 0; i < 8; ++i) { const int kk = 8 * i + (lane >> 3); v[i] = __builtin_nontemporal_load((const GAS f32x4*)(W + (size_t)(k0 + kk) * ldw + n0) + (lane & 7)); }
#pragma unroll
    for (int i = 0; i < 8; ++i) { const int kk = 8 * i + (lane >> 3); const float gk = (gain ? gain[k0 + kk] : 1.f) * wscale; LAS float* d = scr + kk * 33 + 4 * (lane & 7);
        d[0] = v[i].x * gk; d[1] = v[i].y * gk; d[2] = v[i].z * gk; d[3] = v[i].w * gk; }
    LDS_WAIT(); asm volatile("" ::: "memory");
    const int c = lane & 7;
#pragma unroll
    for (int j = 0; j < 4; ++j) { const int n = (lane >> 3) + 8 * j; const LAS float* s = scr + (8 * c) * 33 + n;
        v4u o; o.x = pk2(s[0 * 33], s[1 * 33]); o.y = pk2(s[2 * 33], s[3 * 33]); o.z = pk2(s[4 * 33], s[5 * 33]); o.w = pk2(s[6 * 33], s[7 * 33]);
        *(GAS v4u*)(WT + (size_t)w_drow(mode, n0 + n) * K + k0 + 8 * c) = o; }
    LDS_WAIT(); asm volatile("" ::: "memory");
}
template <int NR> __device__ __forceinline__ void rms_rows_to_bf16(const float* x0, bf16* o0, float* rms0, int lane) {
    f32x4 v[NR][4]; float s[NR];
#pragma unroll
    for (int r = 0; r < NR; ++r) { const GAS f32x4* xr = (const GAS f32x4*)(x0 + (size_t)r * D) + lane;
#pragma unroll
        for (int j = 0; j < 4; ++j) v[r][j] = __builtin_nontemporal_load(xr + 64 * j); }
#pragma unroll
    for (int r = 0; r < NR; ++r) { s[r] = 0.f;
#pragma unroll
        for (int j = 0; j < 4; ++j) s[r] += (v[r][j].x * v[r][j].x + v[r][j].y * v[r][j].y) + (v[r][j].z * v[r][j].z + v[r][j].w * v[r][j].w); }
#pragma unroll
    for (int r = 0; r < NR; ++r) s[r] = xsum32(xsum16(rowsum16(s[r])));
#pragma unroll
    for (int r = 0; r < NR; ++r) { const float rstd = 1.f / sqrtf(s[r] * (1.f / D) + RMS_EPS);
        if (lane == 0) rms0[r] = 1.0f / rstd;
        GAS unsigned long long* o8 = (GAS unsigned long long*)(o0 + (size_t)r * D) + lane;
#pragma unroll
        for (int j = 0; j < 4; ++j) { const f32x4 y = v[r][j] * rstd; o8[64 * j] = (unsigned long long)pk2(y.x, y.y) | ((unsigned long long)pk2(y.z, y.w) << 32); } }
}
__device__ __forceinline__ void sincos_d(double a, float& sn, float& cs) {
    const double k = __builtin_rint(a * 0.63661977236758134308), y = a - k * 1.57079632679489661923, y2 = y * y;
    double s = -1.0 / 1307674368000.0; s = s * y2 + 1.0 / 6227020800.0; s = s * y2 - 1.0 / 39916800.0; s = s * y2 + 1.0 / 362880.0; s = s * y2 - 1.0 / 5040.0; s = s * y2 + 1.0 / 120.0; s = s * y2 - 1.0 / 6.0; s = s * y2 + 1.0; s = s * y;
    double c = 1.0 / 87178291200.0; c = c * y2 - 1.0 / 479001600.0; c = c * y2 + 1.0 / 3628800.0; c = c * y2 - 1.0 / 40320.0; c = c * y2 + 1.0 / 720.0; c = c * y2 - 1.0 / 24.0; c = c * y2 + 0.5; c = 1.0 - c * y2;
    const int q = ((int)k) & 3;
    const double ss = (q == 0) ? s : (q == 1) ? c : (q == 2) ? -s : -c, cc = (q == 0) ? c : (q == 1) ? -s : (q == 2) ? -c : s;
    sn = (float)ss; cs = (float)cc;
}
struct Args { const float* in[21]; float* out; unsigned char* ws; int ph_lo, ph_hi; };
#ifndef W_ITEMS_P0
#define W_ITEMS_P0 (4 * 1408 + 2 * 1408 + 2 * 768 + 512)
#endif
__device__ __forceinline__ void p0_weights(Frame& F, const Args& a, unsigned char* ws, int it_lo, int it_hi);
__device__ __forceinline__ void p0_prologue(Frame& F, const Args& a, unsigned char* ws) {
    const int lane = lane_id();
    LAS float* scr = (LAS float*)(F.lds + RING_OFF + F.wave * 16384);
    const int gw = F.vcu * NWAVES + F.wave, NGW = F.G * NWAVES;
    { bf16* XN = (bf16*)(ws + WS_XN);
      float* R0 = (float*)(ws + WS_RMS0);
      if (F.G == 256) {
          const int xl = F.vcu >> 5, wi = (F.vcu & 31) * NWAVES + F.wave;
          for (int k = 3; k >= 0; --k) { const int m = 4096 * xl + 1024 * k + 4 * wi; rms_rows_to_bf16<4>(a.in[0] + (size_t)m * D, XN + (size_t)m * D, R0 + m, lane); } }
      else for (int m = 4 * gw; m < M; m += 4 * NGW) rms_rows_to_bf16<4>(a.in[0] + (size_t)m * D, XN + (size_t)m * D, R0 + m, lane); }
    p0_weights(F, a, ws, 0, W_ITEMS_P0);
    { GAS v4u* xs = (GAS v4u*)(ws + WS_X); const v4u ones = (v4u){~0u, ~0u, ~0u, ~0u};
      for (int i = gw * 64 + lane; i < (int)(3 * X_BYTES / 16); i += NGW * 64) xs[i] = ones; }
    { float* rope = (float*)(ws + WS_ROPE);
      for (int i = ((NWAVES - 1 - F.wave) * F.G + F.vcu) * 64 + lane; i < SEQ * 8; i += NGW * 64) { const int pos = i >> 3, j = i & 7;
          const unsigned ifb = (j == 0) ? 0x3f800000u : (j == 1) ? 0x3e4693afu : (j == 2) ? 0x3d1a08c8u : (j == 3) ? 0x3beef74eu : (j == 4) ? 0x3ab95d22u : (j == 5) ? 0x398fc8f8u : (j == 6) ? 0x385f10c5u : 0x372d07a8u;
          const float ang = (float)pos * __uint_as_float(ifb); float sn, cs; sincos_d((double)ang, sn, cs); rope[pos * 16 + j] = cs; rope[pos * 16 + 8 + j] = sn; } }
}
__device__ __forceinline__ void p0_weights(Frame& F, const Args& a, unsigned char* ws, int it_lo, int it_hi) {
    const int lane = lane_id();
    LAS float* scr = (LAS float*)(F.lds + RING_OFF + F.wave * 16384);
    const int gw = F.vcu * NWAVES + F.wave, NGW = F.G * NWAVES;
    constexpr int I_GU = (D / 64) * (FF / 32), I_DN = (FF / 64) * (D / 32), I_IN = (D / 64) * (1536 / 32), I_O = (D / 64) * (D / 32);
    constexpr int NITEMS = 4 * I_GU + 2 * I_DN + 2 * I_IN + I_O;
    const int nfull = ((it_hi - it_lo) / NGW) * NGW;
    for (int jt = gw; jt < (it_hi - it_lo) + NGW; jt += NGW) {
        int it;
        if (jt < nfull) it = it_lo + jt;
        else { if (F.wave != 0) break; it = it_lo + nfull + (jt - nfull) / NWAVES; if (it >= it_hi) break; }
        int r = it;
        if (r < I_GU) { p0_transpose_item(a.in[3], FF, D, FF, (bf16*)(ws + WS_WGU1), 1, scr, r, lane, a.in[1]); continue; } r -= I_GU;
        if (r < I_GU) { p0_transpose_item(a.in[4], FF, D, FF, (bf16*)(ws + WS_WGU1), 2, scr, r, lane, a.in[1]); continue; } r -= I_GU;
        if (r < I_DN) { p0_transpose_item(a.in[5], D, FF, D, (bf16*)(ws + WS_WD1), 0, scr, r, lane, nullptr); continue; } r -= I_DN;
        if (r < I_IN) { p0_transpose_item(a.in[8], NIN_SRC, D, 1536, (bf16*)(ws + WS_WIN), 0, scr, r, lane, a.in[6]); continue; } r -= I_IN;
        if (r < I_IN) { p0_transpose_item(a.in[8] + 1544, NIN_SRC, D, 1536, (bf16*)(ws + WS_WIN), 4, scr, r, lane, a.in[6]); continue; } r -= I_IN;
        if (r < I_O)  { p0_transpose_item(a.in[15], D, D, D, (bf16*)(ws + WS_WOUT), 0, scr, r, lane, nullptr); continue; } r -= I_O;
        if (r < I_GU) { p0_transpose_item(a.in[18], FF, D, FF, (bf16*)(ws + WS_WGU2), 1, scr, r, lane, a.in[16]); continue; } r -= I_GU;
        if (r < I_GU) { p0_transpose_item(a.in[19], FF, D, FF, (bf16*)(ws + WS_WGU2), 2, scr, r, lane, a.in[16]); continue; } r -= I_GU;
        p0_transpose_item(a.in[20], D, FF, D, (bf16*)(ws + WS_WD2), 0, scr, r, lane, nullptr);
    }
}
__device__ __forceinline__ void nan_rows_f32(Frame& F, float* out) {
    const int gw = F.vcu * NWAVES + F.wave, NGW = F.G * NWAVES; const float q = __builtin_nanf(""); const int lane = lane_id();
    for (int m = gw; m < M; m += NGW) { GAS f32x4* o = (GAS f32x4*)(out + (size_t)m * D) + lane;
#pragma unroll
        for (int j = 0; j < 4; ++j) o[64 * j] = (f32x4){q, q, q, q}; }
}
__device__ __forceinline__ void wrong_grid_word(Frame& F) {
    if (blockIdx.x == 0 && F.wave == 0 && lane_id() == 0) { unsigned expect = 0u; __hip_atomic_compare_exchange_strong((unsigned*)(F.ctl + CW_CODE), &expect, 0x7f0u, __ATOMIC_RELAXED, __ATOMIC_RELAXED, __HIP_MEMORY_SCOPE_AGENT);
        __hip_atomic_store(F.ctl + CW_TMO, 1u, RLX_AGENT); }
}

__global__ void __launch_bounds__(NWAVES * 64, 2) skel_fwd(Args args) {
    extern __shared__ __attribute__((aligned(16))) unsigned char lds[];
    Frame F;
    F.lds = (LAS unsigned char*)lds;
    F.MISC = (volatile LAS unsigned*)(F.lds + MISC_OFF);
    F.wave = __builtin_amdgcn_readfirstlane((int)threadIdx.x >> 6);
    F.G = gridDim.x; { const int bx = blockIdx.x; F.vcu = (F.G % 8 == 0) ? (bx % 8) * (F.G / 8) + bx / 8 : bx; }
#define GRID_BAR(seam) do { if (N_LAUNCHES == PER_PHASE) { if (F.wave == 0 && lane_id() == 0) __hip_atomic_store(F.ctl + CW_TMO, 0xBADBA0u | (unsigned)(seam), RLX_AGENT); } \
    else { xcd_barrier(bar); } } while (0)
#define XCD_BAR(seam) do { if (N_LAUNCHES == PER_PHASE) { if (F.wave == 0 && lane_id() == 0) __hip_atomic_store(F.ctl + CW_TMO, 0xBADBA0u | (unsigned)(seam), RLX_AGENT); } \
    else { xcd_barrier(bar, xlocal); } } while (0)
    unsigned char* ws = args.ws;
    F.ctl = (gu32*)(ws + WS_CTL);
    bf16* const XN = (bf16*)(ws + WS_XN); bf16* const HB = (bf16*)(ws + WS_H); bf16* const QKV = (bf16*)(ws + WS_QKV); bf16* const MIX = (bf16*)(ws + WS_MIX);
    float* const LOGF = (float*)(ws + WS_LOGF);
    for (int u = F.wave * 64 + lane_id(); u < (LDS_BYTES - LDSCTL_OFF) / 4; u += NWAVES * 64) ((LAS unsigned*)(F.lds + LDSCTL_OFF))[u] = 0u;
    __syncthreads();
    if (F.wave == 0) {
        const int lane = lane_id();
        const float p1 = args.in[10][lane] * args.in[11][lane], p2 = args.in[12][lane] * args.in[13][lane];
        const float s1 = wave_sum(p1), s2 = wave_sum(p2);
        if (lane == 0) ((volatile LAS float*)F.MISC)[16] = expf(s1) - expf(s2) + 0.2f;
    }
    __syncthreads();
    XcdBarrier bar; bar.bar = (unsigned*)(F.ctl + CW_BAR); bar.x = 0; bar.st = nullptr; bar.wave = F.wave;
    if (N_LAUNCHES != PER_PHASE && F.wave == 0 && lane_id() == 0 && (xb_xcc_id() != (blockIdx.x & 7u) || gridDim.x != 256u)) __hip_atomic_fetch_or(F.ctl + CW_XMIS, 1u, RLX_AGENT);
    bool xlocal = false;
    if (N_LAUNCHES != PER_PHASE) bar = xcd_barrier_post((unsigned*)(F.ctl + CW_BAR), F.MISC + 8, F.wave);

    const int lo = args.ph_lo, hi = args.ph_hi;
#define IN(k) (lo <= (k) && (k) < hi)
#define BOTH(k) (IN(k) && IN((k) + 1))

#ifndef REV_P2
#define REV_P2 8
#endif
#ifndef REV_P7
#define REV_P7 REV_P2
#endif
#ifndef REV_P6
#define REV_P6 0
#endif
#ifndef REV_P5
#define REV_P5 0
#endif
#ifndef WGM_FUSED
#define WGM_FUSED 8
#endif
#ifndef WGM_NGU
#define WGM_NGU 4
#endif
#ifndef WGM_NIN
#define WGM_NIN 2
#endif
#ifndef REP0
#define REP0 1
#endif
#ifndef REP1
#define REP1 1
#endif
#ifndef REP3
#define REP3 1
#endif
#ifndef REP4
#define REP4 1
#endif
    if (IN(0)) { for (int rep = 0; rep < REP0; ++rep) { p0_prologue(F, args, ws); LDS_WAIT(); __syncthreads(); } if (BOTH(0)) { GRID_BAR(0); xlocal = (N_LAUNCHES != PER_PHASE) && (__builtin_amdgcn_readfirstlane((int)__hip_atomic_load(F.ctl + CW_XMIS, RLX_AGENT)) == 0); } }

    if (IN(1)) {
#pragma unroll 1
        for (int rep = 1; rep < REP1; ++rep) { pg8::Gemm g{XN, (const bf16*)(ws + WS_WGU1), M, NGU, D}; pg8::StaticOrder S; S.init(M, NGU, F.G, (int)blockIdx.x, WGM_NGU); pg8::EpiSwiglu E{HB, FF, (int)(H_PAD / 2)};
            pg8::gemm_phase<pg8::EpiSwiglu, pg8::StaticOrder, PG8_ALIGN, PG8_SP2>(F.lds + RING_OFF, g, S, E, F.wave); LDS_WAIT(); __syncthreads(); }
        pg8::Gemm g{XN, (const bf16*)(ws + WS_WGU1), M, NGU, D}; pg8::StaticOrder S; S.init(M, NGU, F.G, (int)blockIdx.x, WGM_NGU);
        pg8::EpiSwiglu E{HB, FF, (int)(H_PAD / 2)};
        pg8::gemm_phase<pg8::EpiSwiglu, pg8::StaticOrder, PG8_ALIGN, PG8_SP2>(F.lds + RING_OFF, g, S, E, F.wave);
        if (BOTH(1)) XCD_BAR(1);
    }

    if (IN(2)) {
        unsigned poison = (__hip_atomic_load(F.ctl + CW_TMO, RLX_AGENT) != 0u);
        if (F.G != 256) { nan_rows_f32(F, args.out); wrong_grid_word(F); VM_WAIT(); __syncthreads(); }
        else {
        {
            pg8::Gemm g{HB, (const bf16*)(ws + WS_WD1), M, D, FF, (int)H_PAD}; pg8::StaticOrder S; S.init(M, D, F.G, (int)blockIdx.x, WGM_FUSED, REV_P2);
            pg8::EpiFused<false, 1> E{XN, (const float*)(ws + WS_RMS0), XN, (float*)(ws + WS_RMS1), nullptr, args.in[2], D,
                                      (unsigned long long*)(ws + WS_X + 0 * X_BYTES), (unsigned*)seam_word(F, SB_A, 0), (unsigned*)(F.ctl + CW_TMO), 0x740u, poison};
            E.fill_gains(F.lds + EPI_OFF, F.wave * 64 + lane_id()); LDS_WAIT(); __syncthreads();
            pg8::gemm_phase<pg8::EpiFused<false, 1>, pg8::StaticOrder, true, PG8_SP2>(F.lds + RING_OFF, g, S, E, F.wave, F.lds + EPI_OFF);
        }
        }
        if (BOTH(2)) XCD_BAR(2);
    }

    if (IN(3)) {
#pragma unroll 1
        for (int rep = 0; rep < REP3; ++rep) {
        {
            LAS unsigned short* wt = (LAS unsigned short*)(F.lds + RING_OFF);
            const float* win = args.in[8]; const int lane = lane_id();
            const int c16 = lane & 15, g4 = lane >> 4;
            const int gw = F.vcu * NWAVES + F.wave;
            static_assert(M / 16 == 256 * NWAVES, "one 16-row group per wave of the 256-workgroup grid (any other grid is refused by the fused phases)");
            const int rg = gw & (M / 16 - 1);
            const GAS v4u* xr = (const GAS v4u*)(XN + (size_t)(rg * 16 + c16) * D + 8 * g4);
            v4u xq[32];
#pragma unroll
            for (int kb = 0; kb < 32; ++kb) xq[kb] = xr[kb * 4];
            { f32x4 wv[2][2]; float gk[2];
#pragma unroll
              for (int q = 0; q < 2; ++q) { const int k = F.wave * 64 + lane + 512 * q; const GAS f32x4* src = (const GAS f32x4*)(win + (size_t)k * NIN_SRC + 1536); wv[q][0] = src[0]; wv[q][1] = src[1]; gk[q] = args.in[6][k]; }
#pragma unroll
              for (int q = 0; q < 2; ++q) { const int k = F.wave * 64 + lane + 512 * q; const int kb = k >> 5, g = (k >> 3) & 3, jj = k & 7;
#pragma unroll
                  for (int c = 0; c < 8; ++c) { const float v = wv[q][c >> 2][c & 3] * gk[q]; const unsigned hi = f2bf(v), lo = f2bf(v - __uint_as_float(hi << 16));
                      const int idx = ((kb * 64 + g * 16 + c) * 16) + jj; wt[idx] = (unsigned short)hi; wt[idx + 8] = (unsigned short)lo; } } }
            const float fb = (c16 < 8) ? args.in[9][c16] : 0.f;
            LDS_WAIT(); __syncthreads();
            {
                f32x4 acc0 = (f32x4){0.f, 0.f, 0.f, 0.f}, acc1 = (f32x4){0.f, 0.f, 0.f, 0.f};
#pragma unroll
                for (int kb = 0; kb < 32; ++kb) { const bf16x8 xa = __builtin_bit_cast(bf16x8, xq[kb]);
                    const bf16x8 bh = *(const LAS bf16x8*)(wt + (kb * 64 + lane) * 16), bl = *(const LAS bf16x8*)(wt + (kb * 64 + lane) * 16 + 8);
                    acc0 = __builtin_amdgcn_mfma_f32_16x16x32_bf16(xa, bh, acc0, 0, 0, 0); acc1 = __builtin_amdgcn_mfma_f32_16x16x32_bf16(xa, bl, acc1, 0, 0, 0); }
                const f32x4 acc = acc0 + acc1;
                if (c16 < 8) {
                    f32x4 lf4;
#pragma unroll
                    for (int r = 0; r < 4; ++r) { const float z = acc[r] + fb; lf4[r] = fminf(z, 0.f) - log1pf(expf(-fabsf(z))); }
                    const int row0 = rg * 16 + g4 * 4;
                    *(GAS f32x4*)(LOGF + ((size_t)((row0 >> 11) * 8 + c16) * SEQ + (row0 & (SEQ - 1)))) = lf4; }
            }
            LDS_WAIT(); __syncthreads();
        }
        pg8::Gemm g{XN, (const bf16*)(ws + WS_WIN), M, NIN, D}; pg8::StaticOrder S; S.init(M, NIN, F.G, (int)blockIdx.x, WGM_NIN);
        pg8::EpiQKV E{QKV, NIN, (const float*)(ws + WS_ROPE), attn_body::C2, SEQ - 1, (unsigned*)(F.ctl + CW_STAT)};
        pg8::gemm_phase<pg8::EpiQKV, pg8::StaticOrder, PG8_ALIGN, PG8_SP2>(F.lds + RING_OFF, g, S, E, F.wave);
        if (REP3 > 1) { LDS_WAIT(); __syncthreads(); }
        }
        if (BOTH(3)) XCD_BAR(3);
    }

    if (IN(4)) {
        static_assert(attn_body::ATTN_LDS_BYTES <= RING_BYTES, "attention body geometry vs frame");
        if (F.G != 256) { nan_rows_f32(F, args.out); wrong_grid_word(F); VM_WAIT(); __syncthreads(); }
        else {
        const float lam = ((volatile LAS float*)F.MISC)[16];
#pragma unroll 1
        for (int rep = 0; rep < REP4; ++rep) {
        char* shm = (char*)lds + RING_OFF;
        const int v = F.vcu;
        typedef attn_body::bf16 hb;
#ifndef REPF
#define REPF 1
#endif
#ifndef REPD
#define REPD 1
#endif
        {
            const int bh = v >> 2, b = bh >> 2, h = bh & 3, s = v & 3;
            const hb* base = (const hb*)QKV + (size_t)b * SEQ * NIN; float* scr = (float*)(ws + WS_SCR + (size_t)blockIdx.x * SCR_PER_CU);
#pragma unroll 1
            for (int u = 0; u < 4 * REPD; ++u) { const int qb = ((u >> 1) & 1) ? 7 - s : s, mp = u & 1;
                const int nmp = (u + 1) & 1;
                attn_body::attn_unit128<8>(qb, base + 1536 + h * 128 + mp * 64, base + 2048 + h * 128 + mp * 64, base + 2560 + h * 128, (hb*)MIX + (size_t)b * SEQ * D + 512 + h * 128,
                                           mp == 0 ? 1 : 2, scr, lam, args.in[14], shm, F.wave, u > 0, u + 1 < 4 * REPD, base + 2048 + h * 128 + nmp * 64, base + 2560 + h * 128); }
        }
#pragma unroll 1
        for (int rp = 0; rp < REPF; ++rp) {
            const int bh = v >> 1, s0 = 2 * (v & 1), b = bh >> 3, h = bh & 7;
            const hb* base = (const hb*)QKV + (size_t)b * SEQ * NIN;
            const float qh = __uint_as_float(__hip_atomic_load(F.ctl + CW_STAT + (b * 8 + h) * 2, RLX_AGENT)), kh = __uint_as_float(__hip_atomic_load(F.ctl + CW_STAT + (b * 8 + h) * 2 + 1, RLX_AGENT));
            const float thr = 60.f + 4.f * 1.03f * sqrtf(qh * kh);
            int sk0, sk1, sk2, sk3;
            attn_body::fox_bias_table(LOGF + (size_t)(b * 8 + h) * SEQ, s0 * 256, (7 - s0) * 256, (s0 + 1) * 256, (6 - s0) * 256, shm, F.wave, thr, sk0, sk1, sk2, sk3);
#pragma unroll 1
            for (int j = 0; j < 4; ++j) {
                const int qb = (j == 0) ? s0 : (j == 1) ? 7 - s0 : (j == 2) ? s0 + 1 : 6 - s0, sk = (j == 0) ? sk0 : (j == 1) ? sk1 : (j == 2) ? sk2 : sk3;
                const int nsk = (j == 0) ? sk1 : (j == 1) ? sk2 : sk3;
                attn_body::attn_unit<8, true>(qb, sk, base + h * 64, base + 512 + h * 64, base + 1024 + h * 64, (hb*)MIX + (size_t)b * SEQ * D + h * 64, 0, nullptr, 0, 0.f, nullptr, shm, F.wave,
                                              j > 0, j < 3, base + 512 + h * 64 + (size_t)nsk * 64 * NIN, base + 1024 + h * 64 + (size_t)nsk * 64 * NIN); }
        }
        }
        }
        if (BOTH(4)) XCD_BAR(4);
    }

    if (IN(5)) {
        unsigned poison = (__hip_atomic_load(F.ctl + CW_TMO, RLX_AGENT) != 0u);
        if (F.G != 256) { nan_rows_f32(F, args.out); wrong_grid_word(F); VM_WAIT(); __syncthreads(); }
        else {
        {
            pg8::Gemm g{MIX, (const bf16*)(ws + WS_WOUT), M, D, D}; pg8::StaticOrder S; S.init(M, D, F.G, (int)blockIdx.x, WGM_FUSED, REV_P5);
            pg8::EpiFused<false, 2> E{XN, (const float*)(ws + WS_RMS1), XN, (float*)(ws + WS_RMS2), nullptr, args.in[7], D,
                                      (unsigned long long*)(ws + WS_X + 1 * X_BYTES), (unsigned*)seam_word(F, SB_B, 0), (unsigned*)(F.ctl + CW_TMO), 0x840u, poison};
            E.fill_gains(F.lds + EPI_OFF, F.wave * 64 + lane_id()); LDS_WAIT(); __syncthreads();
            pg8::gemm_phase<pg8::EpiFused<false, 2>, pg8::StaticOrder, true, PG8_SP2>(F.lds + RING_OFF, g, S, E, F.wave, F.lds + EPI_OFF);
        }
        }
        if (BOTH(5)) XCD_BAR(5);
    }

    if (IN(6)) {
        pg8::Gemm g{XN, (const bf16*)(ws + WS_WGU2), M, NGU, D}; pg8::StaticOrder S; S.init(M, NGU, F.G, (int)blockIdx.x, WGM_NGU, REV_P6);
        pg8::EpiSwiglu E{HB, FF, (int)(H_PAD / 2)};
        pg8::gemm_phase<pg8::EpiSwiglu, pg8::StaticOrder, PG8_ALIGN, PG8_SP2>(F.lds + RING_OFF, g, S, E, F.wave);
        if (BOTH(6)) XCD_BAR(6);
    }

    if (IN(7)) {
        unsigned poison = (__hip_atomic_load(F.ctl + CW_TMO, RLX_AGENT) != 0u);
        if (N_LAUNCHES != PER_PHASE) poison |= __hip_atomic_load((gu32*)((const unsigned*)(F.ctl + CW_BAR) + XB_TMO), RLX_AGENT) != 0u;
        if (F.G != 256) { nan_rows_f32(F, args.out); wrong_grid_word(F); }
        else {
        {
            pg8::Gemm g{HB, (const bf16*)(ws + WS_WD2), M, D, FF, (int)H_PAD}; pg8::StaticOrder S; S.init(M, D, F.G, (int)blockIdx.x, WGM_FUSED, REV_P7);
            pg8::EpiFused<true, 1> E{XN, (const float*)(ws + WS_RMS2), nullptr, nullptr, args.out, args.in[17], D,
                                     (unsigned long long*)(ws + WS_X + 2 * X_BYTES), (unsigned*)seam_word(F, SB_C, 0), (unsigned*)(F.ctl + CW_TMO), 0x700u, poison};
            E.fill_gains(F.lds + EPI_OFF, F.wave * 64 + lane_id()); LDS_WAIT(); __syncthreads();
            pg8::gemm_phase<pg8::EpiFused<true, 1>, pg8::StaticOrder, true, PG8_SP2>(F.lds + RING_OFF, g, S, E, F.wave, F.lds + EPI_OFF);
        }
        }
    }
#undef IN
#undef BOTH
}

extern "C" void kernel_launch(void* const* d_in, const int* in_sizes, int n_in, void* d_out, int out_size, void* d_ws, size_t ws_size, hipStream_t stream) {
    static int grid = 0;
    if (grid == 0) {
        if (n_in != 21 || in_sizes[0] != M * D || out_size != M * D || ws_size < WS_END) { fprintf(stderr, "kernel_launch: built for 21 inputs, x and out of %d floats, >= %zu bytes of workspace; got n_in %d, in0 %d, out %d, ws %zu; nothing launched\n", M * D, (size_t)WS_END, n_in, n_in > 0 ? in_sizes[0] : -1, out_size, ws_size); grid = -1; return; }
        int dev = 0, cus = 0, per_cu = 0;
        if (hipGetDevice(&dev) != hipSuccess || hipDeviceGetAttribute(&cus, hipDeviceAttributeMultiprocessorCount, dev) != hipSuccess) { fprintf(stderr, "kernel_launch: hipGetDevice / hipDeviceGetAttribute failed; nothing launched\n"); grid = -1; return; }
        if (hipFuncSetAttribute((const void*)skel_fwd, hipFuncAttributeMaxDynamicSharedMemorySize, LDS_BYTES) != hipSuccess) { fprintf(stderr, "kernel_launch: hipFuncSetAttribute failed: this kernel needs %d bytes of dynamic LDS per workgroup; nothing launched\n", LDS_BYTES); grid = -1; return; }
        if (hipOccupancyMaxActiveBlocksPerMultiprocessor(&per_cu, (const void*)skel_fwd, NWAVES * 64, LDS_BYTES) != hipSuccess || per_cu < 1)
            fprintf(stderr, "kernel_launch: note: the occupancy query reports %d workgroups per CU; the launch goes ahead with one per CU (%d bytes of LDS each)\n", per_cu, LDS_BYTES);
        (void)hipGetLastError();
        grid = cus;
        if (grid != 256) fprintf(stderr, "kernel_launch: launching %d workgroups; the fused phases need exactly 256, so every output will be NaN by design\n", grid);
    }
    if (grid < 0) return;
    if (hipMemsetAsync((char*)d_ws + WS_CTL, 0, CTL_ZERO_BYTES, stream) != hipSuccess) { fprintf(stderr, "kernel_launch: hipMemsetAsync of the control words failed; nothing launched\n"); return; }
    Args a{};
    for (int i = 0; i < 21; ++i) a.in[i] = (const float*)d_in[i];
    a.out = (float*)d_out; a.ws = (unsigned char*)d_ws;
    for (int li = 0; li < N_LAUNCHES; ++li) {
        a.ph_lo = (N_LAUNCHES == PER_PHASE) ? li : 0; a.ph_hi = (N_LAUNCHES == PER_PHASE) ? li + 1 : PER_PHASE;
        hipLaunchKernelGGL(skel_fwd, dim3(grid), dim3(NWAVES * 64), LDS_BYTES, stream, a);
        const hipError_t le = hipPeekAtLastError();
        if (le != hipSuccess) { fprintf(stderr, "kernel_launch: launch %d failed: %s (grid %d x %d threads, %d B LDS)\n", li, hipGetErrorName(le), grid, NWAVES * 64, LDS_BYTES); break; }
    }
}
```
